# Optimizing an MI355X kernel written in HIP

```python
import jax, jax.numpy as jnp
from jax import lax
import numpy as np

D_MODEL = 2048
BATCH = 4
SEQ = 4096
DEPTH = 1
DEC_BATCH = 128
DEC_SEQ = 4
PAST_LEN = 16384
PAGE_SIZE = 128

RET_HEADS = 8
RET_DK = 64
RET_DV = 128
RET_WIDTH = RET_HEADS * RET_DV
RET_CHUNK = 128
SWA_HEADS = 16
SWA_KV_HEADS = 2
SWA_DH = 64
SWA_GROUP = SWA_HEADS // SWA_KV_HEADS
SWA_WIDTH = SWA_HEADS * SWA_DH
WINDOW = 128
SWA_BLOCK = 128
MIX_WIDTH = RET_WIDTH + SWA_WIDTH
PROJ_SIZES = (RET_HEADS * RET_DK, RET_HEADS * RET_DK, RET_WIDTH, RET_WIDTH,
              SWA_WIDTH, SWA_KV_HEADS * SWA_DH, SWA_KV_HEADS * SWA_DH)
PROJ_WIDTH = 2 * RET_HEADS * RET_DK + 2 * RET_WIDTH + SWA_WIDTH + 2 * SWA_KV_HEADS * SWA_DH
D_FF = 5632
CONV_W = 3
ROPE_THETA = 10000.0
EPS = 1e-6

kernel_name = 'hymba_retention_swa_sink_convffn_step'

F32 = jnp.float32


def rmsnorm(x, w):
    xf = x.astype(F32)
    y = xf * lax.rsqrt(jnp.mean(xf * xf, axis=-1, keepdims=True) + EPS) * w.astype(F32)
    return y.astype(x.dtype)


def rope(x, pos):
    half = x.shape[-1] // 2
    inv = ROPE_THETA ** (-jnp.arange(half, dtype=F32) / half)
    ang = pos.astype(F32)[:, None] * inv[None, :]
    cos = jnp.cos(ang)[None, :, None, :]
    sin = jnp.sin(ang)[None, :, None, :]
    x1 = x[..., :half].astype(F32)
    x2 = x[..., half:].astype(F32)
    return jnp.concatenate([x1 * cos - x2 * sin, x2 * cos + x1 * sin], axis=-1).astype(x.dtype)


def ret_log_decay():
    return jnp.log1p(-jnp.exp2(-5.0 - jnp.arange(RET_HEADS, dtype=F32)))


def retention_chunk(S, qkv):
    q, k, v = qkv
    C = q.shape[1]
    lg = ret_log_decay()
    idx = jnp.arange(C, dtype=F32)
    diff = idx[:, None] - idx[None, :]
    causal = diff >= 0
    dmask = jnp.where(causal[None], jnp.exp(jnp.where(causal, diff, 0.0)[None] * lg[:, None, None]), 0.0)
    scores = jnp.einsum('bihd,bjhd->bhij', q, k) * dmask[None]
    o = jnp.einsum('bhij,bjhv->bihv', scores, v)
    o = o + jnp.einsum('bihd,bhdv->bihv', q, S) * jnp.exp((idx + 1.0)[:, None] * lg[None, :])[None, :, :, None]
    k_dec = k * jnp.exp((C - 1.0 - idx)[:, None] * lg[None, :])[None, :, :, None]
    S_new = S * jnp.exp(C * lg)[None, :, None, None] + jnp.einsum('bjhd,bjhv->bhdv', k_dec, v)
    return S_new, o


def retention_prompt(q, k, v):
    B, T = q.shape[:2]
    nc = T // RET_CHUNK
    def chunks(x):
        return jnp.moveaxis(x.astype(F32).reshape(B, nc, RET_CHUNK, x.shape[2], x.shape[3]), 1, 0)
    S0 = jnp.zeros((B, RET_HEADS, RET_DK, RET_DV), F32)
    S_fin, o = lax.scan(retention_chunk, S0, (chunks(q), chunks(k), chunks(v)))
    o = jnp.moveaxis(o, 0, 1).reshape(B, T, RET_HEADS, RET_DV)
    return S_fin, o


def sink_attention(q, kk, vv, qpos, kpos, sinks):
    s = jnp.einsum('bnqkgd,bnskd->bnkgqs', q.astype(F32), kk.astype(F32)) * (SWA_DH ** -0.5)
    rel = qpos[:, :, None] - kpos[:, None, :]
    mask = (rel >= 0) & (rel <= WINDOW) & (kpos[:, None, :] >= 0)
    s = jnp.where(mask[None, :, None, None], s, -jnp.inf)
    sink = sinks.astype(F32).reshape(1, 1, SWA_KV_HEADS, SWA_GROUP, 1, 1)
    m = jnp.maximum(jnp.max(s, axis=-1, keepdims=True), sink)
    p = jnp.exp(s - m)
    p = p / (jnp.sum(p, axis=-1, keepdims=True) + jnp.exp(sink - m))
    return jnp.einsum('bnkgqs,bnskd->bnqkgd', p, vv.astype(F32))


def swa_prompt(q, k, v, sinks):
    B, T = q.shape[:2]
    nb = T // SWA_BLOCK
    qb = q.reshape(B, nb, SWA_BLOCK, SWA_KV_HEADS, SWA_GROUP, SWA_DH)
    def band(x):
        xb = x.reshape(B, nb, SWA_BLOCK, SWA_KV_HEADS, SWA_DH)
        prev = jnp.concatenate([jnp.zeros_like(xb[:, :1]), xb[:, :-1]], axis=1)
        return jnp.concatenate([prev, xb], axis=2)
    qpos = jnp.arange(T, dtype=jnp.int32).reshape(nb, SWA_BLOCK)
    kpos = qpos[:, :1] - SWA_BLOCK + jnp.arange(2 * SWA_BLOCK, dtype=jnp.int32)[None, :]
    o = sink_attention(qb, band(k), band(v), qpos, kpos, sinks)
    return o.reshape(B, T, SWA_WIDTH)


def swa_sample(q, k, v, kbuf, vbuf, pos, sinks):
    B, T = q.shape[:2]
    kk = jnp.concatenate([kbuf.astype(k.dtype), k], axis=1)
    vv = jnp.concatenate([vbuf.astype(v.dtype), v], axis=1)
    qb = q.reshape(B, 1, T, SWA_KV_HEADS, SWA_GROUP, SWA_DH)
    kpos = jnp.concatenate([PAST_LEN - WINDOW + jnp.arange(WINDOW, dtype=jnp.int32), pos])[None, :]
    o = sink_attention(qb, kk[:, None], vv[:, None], pos[None, :], kpos, sinks)
    return o.reshape(B, T, SWA_WIDTH), kk[:, -WINDOW:], vv[:, -WINDOW:]


def mixer_inputs(h, pos, w_in, q_norm_w, k_norm_w):
    B, T, _ = h.shape
    proj = jnp.einsum('btd,de->bte', h, w_in)
    split_at = np.cumsum(PROJ_SIZES)[:-1].tolist()
    rq, rk, rv, rg, sq, sk, sv = jnp.split(proj, split_at, axis=-1)
    rq = rope(rq.reshape(B, T, RET_HEADS, RET_DK), pos)
    rk = rope(rk.reshape(B, T, RET_HEADS, RET_DK), pos) * (RET_DK ** -0.5)
    rv = rv.reshape(B, T, RET_HEADS, RET_DV)
    sq = rope(rmsnorm(sq.reshape(B, T, SWA_HEADS, SWA_DH), q_norm_w), pos)
    sk = rope(rmsnorm(sk.reshape(B, T, SWA_KV_HEADS, SWA_DH), k_norm_w), pos)
    sv = sv.reshape(B, T, SWA_KV_HEADS, SWA_DH)
    return rq, rk, rv, rg, sq, sk, sv


def mixer_output(ret_o, rg, swa_o, ret_gn_w, w_o, dtype):
    B, T = ret_o.shape[:2]
    mu = jnp.mean(ret_o, axis=-1, keepdims=True)
    var = jnp.mean(jnp.square(ret_o - mu), axis=-1, keepdims=True)
    on = ((ret_o - mu) * lax.rsqrt(var + EPS)).reshape(B, T, RET_WIDTH) * ret_gn_w.astype(F32)
    ret_out = jax.nn.silu(rg.astype(F32)) * on
    cat = jnp.concatenate([ret_out, swa_o], axis=-1).astype(dtype)
    return jnp.einsum('bte,ed->btd', cat, w_o)


def conv_ffn(h, conv_buf, ffn_norm_w, w_up, conv_w, conv_b, w_down):
    T = h.shape[1]
    hn = rmsnorm(h, ffn_norm_w)
    up = jnp.einsum('btd,df->btf', hn, w_up)
    g, u = jnp.split(up, 2, axis=-1)
    gp = jnp.concatenate([conv_buf.astype(g.dtype), g], axis=1)
    gc = conv_b + sum(gp[:, j:j + T] * conv_w[j] for j in range(CONV_W))
    y = jnp.einsum('btf,fd->btd', jax.nn.silu(gc) * u, w_down)
    return y, gp[:, -(CONV_W - 1):]


def setup_inputs(seed: int = 0) -> dict:
    key = jax.random.key(seed)
    ks = jax.random.split(key, 18)
    def nrm(k, shape, scale):
        return jax.random.normal(k, shape, F32) * scale
    return {
        'x_prompt': nrm(ks[0], (BATCH, SEQ, D_MODEL), 1.0),
        'x_sample': nrm(ks[1], (DEC_BATCH, DEC_SEQ, D_MODEL), 1.0),
        'state_ret': nrm(ks[2], (DEPTH, DEC_BATCH, RET_HEADS, RET_DK, RET_DV), 0.5),
        'cache_swa_k': nrm(ks[3], (DEPTH, DEC_BATCH, WINDOW, SWA_KV_HEADS, SWA_DH), 1.0),
        'cache_swa_v': nrm(ks[4], (DEPTH, DEC_BATCH, WINDOW, SWA_KV_HEADS, SWA_DH), 1.0),
        'state_conv': nrm(ks[5], (DEPTH, DEC_BATCH, CONV_W - 1, D_FF), 1.0),
        'attn_norm_w': 1.0 + nrm(ks[6], (DEPTH, D_MODEL), 0.02),
        'w_in': nrm(ks[7], (DEPTH, D_MODEL, PROJ_WIDTH), D_MODEL ** -0.5),
        'swa_q_norm_w': 1.0 + nrm(ks[8], (DEPTH, SWA_DH), 0.02),
        'swa_k_norm_w': 1.0 + nrm(ks[9], (DEPTH, SWA_DH), 0.02),
        'swa_sinks': nrm(ks[10], (DEPTH, SWA_HEADS), 1.0),
        'ret_gn_w': 1.0 + nrm(ks[11], (DEPTH, RET_WIDTH), 0.02),
        'w_o': nrm(ks[12], (DEPTH, MIX_WIDTH, D_MODEL), MIX_WIDTH ** -0.5),
        'ffn_norm_w': 1.0 + nrm(ks[13], (DEPTH, D_MODEL), 0.02),
        'w_up': nrm(ks[14], (DEPTH, D_MODEL, 2 * D_FF), D_MODEL ** -0.5),
        'conv_w': nrm(ks[15], (DEPTH, CONV_W, D_FF), CONV_W ** -0.5),
        'conv_b': nrm(ks[16], (DEPTH, D_FF), 0.01),
        'w_down': nrm(ks[17], (DEPTH, D_FF, D_MODEL), D_FF ** -0.5),
    }


def reference(x_prompt, x_sample, state_ret, cache_swa_k, cache_swa_v, state_conv,
              attn_norm_w, w_in, swa_q_norm_w, swa_k_norm_w, swa_sinks, ret_gn_w, w_o,
              ffn_norm_w, w_up, conv_w, conv_b, w_down):
    pos_p = jnp.arange(SEQ, dtype=jnp.int32)
    pos_s = PAST_LEN + jnp.arange(DEC_SEQ, dtype=jnp.int32)
    hp, hs = x_prompt, x_sample
    ret_p, ret_s, kp, ks_, vp, vs, cp, cs = [], [], [], [], [], [], [], []
    for l in range(DEPTH):
        a = rmsnorm(hp, attn_norm_w[l])
        rq, rk, rv, rg, sq, sk, sv = mixer_inputs(a, pos_p, w_in[l], swa_q_norm_w[l], swa_k_norm_w[l])
        S_p, ro = retention_prompt(rq, rk, rv)
        so = swa_prompt(sq, sk, sv, swa_sinks[l])
        hp = hp + mixer_output(ro, rg, so, ret_gn_w[l], w_o[l], hp.dtype)
        zbuf = jnp.zeros((hp.shape[0], CONV_W - 1, D_FF), hp.dtype)
        f, cbuf_p = conv_ffn(hp, zbuf, ffn_norm_w[l], w_up[l], conv_w[l], conv_b[l], w_down[l])
        hp = hp + f
        ret_p.append(S_p.astype(state_ret.dtype))
        kp.append(sk[:, -WINDOW:].astype(cache_swa_k.dtype))
        vp.append(sv[:, -WINDOW:].astype(cache_swa_v.dtype))
        cp.append(cbuf_p.astype(state_conv.dtype))
        a = rmsnorm(hs, attn_norm_w[l])
        rq, rk, rv, rg, sq, sk, sv = mixer_inputs(a, pos_s, w_in[l], swa_q_norm_w[l], swa_k_norm_w[l])
        S_s, ro = retention_chunk(state_ret[l].astype(F32), (rq.astype(F32), rk.astype(F32), rv.astype(F32)))
        so, kbuf_s, vbuf_s = swa_sample(sq, sk, sv, cache_swa_k[l], cache_swa_v[l], pos_s, swa_sinks[l])
        hs = hs + mixer_output(ro, rg, so, ret_gn_w[l], w_o[l], hs.dtype)
        f, cbuf_s = conv_ffn(hs, state_conv[l], ffn_norm_w[l], w_up[l], conv_w[l], conv_b[l], w_down[l])
        hs = hs + f
        ret_s.append(S_s.astype(state_ret.dtype))
        ks_.append(kbuf_s.astype(cache_swa_k.dtype))
        vs.append(vbuf_s.astype(cache_swa_v.dtype))
        cs.append(cbuf_s.astype(state_conv.dtype))
    return (hp, hs, jnp.stack(ret_p), jnp.stack(ret_s), jnp.stack(kp), jnp.stack(ks_),
            jnp.stack(vp), jnp.stack(vs), jnp.stack(cp), jnp.stack(cs))
```

```cpp
#include <hip/hip_runtime.h>
#include <hip/hip_cooperative_groups.h>
#include <cstdio>
#include <cstdint>
#include <cmath>
namespace cg = cooperative_groups;
namespace pg8 {
#define PG8_LAS __attribute__((address_space(3)))
typedef unsigned short bf16_t;
typedef short bf16x8 __attribute__((ext_vector_type(8)));
typedef float f32x4 __attribute__((ext_vector_type(4)));
typedef unsigned u32x4 __attribute__((ext_vector_type(4)));
constexpr int BM = 256, BK = 64, HALF = 128, HTB = HALF * BK * 2  , STAGE_BYTES = 8 * HTB, NXCD = 8, WGM = 8;

__host__ __device__ __forceinline__ int lds_byte(int r, int c) { const int st = (r >> 4) * 2 + (c >> 5), rr = r & 15, cc = c & 31, ob = rr * 64 + cc * 2; return st * 1024 + (ob ^ (((ob >> 9) & 1) << 5)); }
__host__ __device__ __forceinline__ void stage_rc(int b, int& R, int& C) { const int st = b / 1024, sb = b % 1024, swz = sb ^ (((sb >> 9) & 1) << 5); R = (st >> 1) * 16 + swz / 64; C = (st & 1) * 32 + (swz % 64) / 2; }
__host__ __device__ __forceinline__ int perm32(int rho) { const int n = rho >> 4, i = rho & 15; return 8 * (i >> 2) + 4 * n + (i & 3); }

struct Unit { int pm, pn, kt0, nt; };
struct Gemm { const bf16_t* A; const bf16_t* Bt; int M, N, K; int a_ktm; };

struct StaticOrder {
    int nM, nN, nwg, G, c, ntk, wgm;
    __host__ __device__ void init(int M, int N, int G_, int c_, int K_, int wgm_ = WGM) { nM = M / BM; nN = N / BM; nwg = nM * nN; G = G_; c = c_; ntk = K_ / BK; wgm = wgm_; }
    __host__ __device__ __forceinline__ bool next(int i, Unit& u) const {
        const long L = (long)i * G + c; if (L >= nwg) return false;
        int wgid = (int)L; { const int q = nwg / NXCD, r = nwg % NXCD, xcd = wgid % NXCD, off = wgid / NXCD; wgid = (xcd < r ? xcd * (q + 1) : r * (q + 1) + (xcd - r) * q) + off; }
        const int nig = wgm * nN, gid = wgid / nig, fm = gid * wgm, gsz = (nM - fm) < wgm ? (nM - fm) : wgm;
        u.pm = fm + ((wgid % nig) % gsz); u.pn = (wgid % nig) / gsz; u.kt0 = 0; u.nt = ntk; return true;
    }
    __device__ __forceinline__ void a_ready(const Unit&) const {}
    __device__ __forceinline__ void done(const Unit&) const {}
};

template <int KS> struct TailSplitOrder {
    StaticOrder so; int ntk;
    __host__ __device__ void init(int N, int G_, int c_, int K_, int wgm_) { so.init(16384, N, G_, c_, K_, wgm_); ntk = K_ / BK; }
    __host__ __device__ __forceinline__ bool next(int i, Unit& u) const {
        const long L = (long)i * so.G + so.c; Unit a; a.pm = 0; a.pn = 0; a.kt0 = 0; a.nt = ntk;
        const bool okA = so.next(i, a);
        const int s = (int)(L - so.nwg); const bool okB = (s >= 0) && (s < 2 * so.nN * KS);
        const int ks = s % KS, t = s / KS; const int ntb = ntk / KS;
        u.pm = okA ? a.pm : 64 + t / so.nN; u.pn = okA ? a.pn : t % so.nN; u.nt = okA ? a.nt : ntb; u.kt0 = okA ? 0 : ks * ntb;
        return okA || okB;
    }
    __device__ __forceinline__ void a_ready(const Unit&) const {}
    __device__ __forceinline__ void done(const Unit&) const {}
};

__device__ __forceinline__ unsigned cvt_pk_bf16(float lo, float hi) { unsigned r; asm volatile("v_cvt_pk_bf16_f32 %0, %1, %2" : "=v"(r) : "v"(lo), "v"(hi)); return r; }
constexpr int MROWS_PROMPT = 16384;
struct EpiProj {
    static constexpr bool PERM = true, AFTER_DRAIN = false;
    bf16_t* O; int ldc;
    __device__ __forceinline__ void operator()(const f32x4 (&acc)[2][2][4][2], const Unit& u, int wr, int wc, int fr, int fq) const {
        const int row0 = u.pm * BM + wr * 64 + fr; const int col0 = u.pn * BM + wc * 32 + 8 * fq;
#pragma unroll
        for (int ai = 0; ai < 2; ++ai)
#pragma unroll
            for (int m = 0; m < 4; ++m) { bf16_t* rowp = O + (size_t)(row0 + ai * HALF + m * 16) * ldc + col0;
#pragma unroll
                for (int bj = 0; bj < 2; ++bj) { const f32x4 v0 = acc[ai][bj][m][0], v1 = acc[ai][bj][m][1];
                    u32x4 w; w.x = cvt_pk_bf16(v0[0], v0[1]); w.y = cvt_pk_bf16(v0[2], v0[3]); w.z = cvt_pk_bf16(v1[0], v1[1]); w.w = cvt_pk_bf16(v1[2], v1[3]);
                    *(u32x4*)(rowp + bj * HALF) = w; } }
    }
};
struct EpiOut {
    static constexpr bool PERM = true, AFTER_DRAIN = false;
    const float* xp; const float* xs; float* out; bf16_t* hb; float* ssq; float* part; int ntk;
    __device__ __forceinline__ void operator()(const f32x4 (&acc)[2][2][4][2], const Unit& u, int wr, int wc, int fr, int fq) const {
        const int row0 = u.pm * BM + wr * 64 + fr; const int col0 = u.pn * BM + wc * 32 + 8 * fq;
        if (u.nt != ntk) {
            float* pp = part + (size_t)(u.kt0 / u.nt) * (512 * 2048);
#pragma unroll
            for (int ai = 0; ai < 2; ++ai)
#pragma unroll
                for (int m = 0; m < 4; ++m) { const size_t off = (size_t)(row0 + ai * HALF + m * 16 - MROWS_PROMPT) * 2048 + col0;
#pragma unroll
                    for (int bj = 0; bj < 2; ++bj) { *(f32x4*)(pp + off + bj * HALF) = acc[ai][bj][m][0]; *(f32x4*)(pp + off + bj * HALF + 4) = acc[ai][bj][m][1]; } }
            return;
        }
        const float* xb = xp;
#pragma unroll
        for (int ai = 0; ai < 2; ++ai) {
            f32x4 pre[4][2][2];
#pragma unroll
            for (int m = 0; m < 4; ++m) { const size_t off = (size_t)(row0 + ai * HALF + m * 16) * 2048 + col0;
#pragma unroll
                for (int bj = 0; bj < 2; ++bj) { pre[m][bj][0] = __builtin_nontemporal_load((const f32x4*)(xb + off + bj * HALF)); pre[m][bj][1] = __builtin_nontemporal_load((const f32x4*)(xb + off + bj * HALF + 4)); } }
#pragma unroll
            for (int m = 0; m < 4; ++m) { const int row = row0 + ai * HALF + m * 16; const size_t off = (size_t)row * 2048 + col0; float ss = 0.f;
#pragma unroll
                for (int bj = 0; bj < 2; ++bj) { const f32x4 h0 = pre[m][bj][0] + acc[ai][bj][m][0], h1 = pre[m][bj][1] + acc[ai][bj][m][1];
                    u32x4 w; w.x = cvt_pk_bf16(h0[0], h0[1]); w.y = cvt_pk_bf16(h0[2], h0[3]); w.z = cvt_pk_bf16(h1[0], h1[1]); w.w = cvt_pk_bf16(h1[2], h1[3]);
                    *(u32x4*)(hb + off + bj * HALF) = w;
                    ss += (h0[0] * h0[0] + h0[1] * h0[1]) + (h0[2] * h0[2] + h0[3] * h0[3]) + (h1[0] * h1[0] + h1[1] * h1[1]) + (h1[2] * h1[2] + h1[3] * h1[3]); }
                ss += __shfl_xor(ss, 16); ss += __shfl_xor(ss, 32);
                if (fq == 0) unsafeAtomicAdd(ssq + row, ss); }
        }
    }
};
struct EpiUpAct {
    static constexpr bool PERM = true, AFTER_DRAIN = false;
    bf16_t* ACT; bf16_t* GSB; bf16_t* USB; float* GHF; float* UHF; float* GHL; const float* ssq; const float* conv_w; const float* conv_b; PG8_LAS float* halo;
    __device__ __forceinline__ void operator()(f32x4 (&acc)[2][2][4][2], const Unit& u, int wr, int wc, int fr, int fq) const {
        const int row0 = u.pm * BM + wr * 64 + fr; const int f0 = u.pn * 128 + wc * 32 + 8 * fq;
        float cw0[8], cw1[8], cw2[8], cb[8];
#pragma unroll
        for (int k = 0; k < 2; ++k) { const f32x4 a = *(const f32x4*)(conv_w + f0 + 4 * k), b = *(const f32x4*)(conv_w + 5632 + f0 + 4 * k), c = *(const f32x4*)(conv_w + 2 * 5632 + f0 + 4 * k), d = *(const f32x4*)(conv_b + f0 + 4 * k);
#pragma unroll
            for (int e = 0; e < 4; ++e) { cw0[4 * k + e] = a[e]; cw1[4 * k + e] = b[e]; cw2[4 * k + e] = c[e]; cb[4 * k + e] = d[e]; } }
        float rsv[2][4];
#pragma unroll
        for (int ai = 0; ai < 2; ++ai)
#pragma unroll
            for (int m = 0; m < 4; ++m) rsv[ai][m] = ssq[row0 + ai * HALF + m * 16];
#pragma unroll
        for (int ai = 0; ai < 2; ++ai)
#pragma unroll
            for (int m = 0; m < 4; ++m) { const float rs = 1.0f / sqrtf(rsv[ai][m] * (1.0f / 2048.0f) + 1e-6f);
#pragma unroll
                for (int bj = 0; bj < 2; ++bj) { acc[ai][bj][m][0] = acc[ai][bj][m][0] * rs; acc[ai][bj][m][1] = acc[ai][bj][m][1] * rs; } }
        if (u.pm >= 64) {
#pragma unroll
            for (int ai = 0; ai < 2; ++ai)
#pragma unroll
                for (int m = 0; m < 4; ++m) { const size_t off = (size_t)(row0 + ai * HALF + m * 16 - MROWS_PROMPT) * 5632 + f0;
                    u32x4 w; w.x = cvt_pk_bf16(acc[ai][0][m][0][0], acc[ai][0][m][0][1]); w.y = cvt_pk_bf16(acc[ai][0][m][0][2], acc[ai][0][m][0][3]); w.z = cvt_pk_bf16(acc[ai][0][m][1][0], acc[ai][0][m][1][1]); w.w = cvt_pk_bf16(acc[ai][0][m][1][2], acc[ai][0][m][1][3]);
                    *(u32x4*)(GSB + off) = w;
                    w.x = cvt_pk_bf16(acc[ai][1][m][0][0], acc[ai][1][m][0][1]); w.y = cvt_pk_bf16(acc[ai][1][m][0][2], acc[ai][1][m][0][3]); w.z = cvt_pk_bf16(acc[ai][1][m][1][0], acc[ai][1][m][1][1]); w.w = cvt_pk_bf16(acc[ai][1][m][1][2], acc[ai][1][m][1][3]);
                    *(u32x4*)(USB + off) = w; }
            return;
        }
        if (fr >= 14) {
#pragma unroll
            for (int ai = 0; ai < 2; ++ai) { PG8_LAS float* hp = halo + ((ai * 2 + wr) * 2 + (fr - 14)) * 128 + wc * 32 + 8 * fq; *(PG8_LAS f32x4*)hp = acc[ai][0][3][0]; *(PG8_LAS f32x4*)(hp + 4) = acc[ai][0][3][1]; }
            if (wr == 1) { float* gp = GHL + ((size_t)u.pm * 2 + (fr - 14)) * 5632 + f0; *(f32x4*)gp = acc[1][0][3][0]; *(f32x4*)(gp + 4) = acc[1][0][3][1]; }
        }
        if (wr == 0 && fr < 2) { float* gp = GHF + ((size_t)u.pm * 2 + fr) * 5632 + f0; *(f32x4*)gp = acc[0][0][0][0]; *(f32x4*)(gp + 4) = acc[0][0][0][1];
            float* up = UHF + ((size_t)u.pm * 2 + fr) * 5632 + f0; *(f32x4*)up = acc[0][1][0][0]; *(f32x4*)(up + 4) = acc[0][1][0][1]; }
        asm volatile("s_waitcnt lgkmcnt(0)" ::: "memory"); __builtin_amdgcn_s_barrier(); asm volatile("" ::: "memory");
#pragma unroll
        for (int ai = 0; ai < 2; ++ai) {
            const int pb = ai * 2 + wr - 1;
            float prev[8];
            if (pb >= 0) { const PG8_LAS float* hp = halo + (pb * 2 + (fr & 1)) * 128 + wc * 32 + 8 * fq; const f32x4 a = *(const PG8_LAS f32x4*)hp, b = *(const PG8_LAS f32x4*)(hp + 4);
#pragma unroll
                for (int e = 0; e < 4; ++e) { prev[e] = a[e]; prev[4 + e] = b[e]; } }
            else {
#pragma unroll
                for (int k = 0; k < 8; ++k) prev[k] = 0.f; }
#pragma unroll
            for (int m = 0; m < 4; ++m) {
                float a[8];
#pragma unroll
                for (int kk = 0; kk < 4; ++kk) {
                    typedef float f32x2p __attribute__((ext_vector_type(2)));
                    const int k = 2 * kk;
                    const f32x2p g2 = {acc[ai][0][m][k >> 2][k & 3], acc[ai][0][m][k >> 2][(k & 3) + 1]}, u2 = {acc[ai][1][m][k >> 2][k & 3], acc[ai][1][m][k >> 2][(k & 3) + 1]};
                    f32x2p p1v, p2v;
#pragma unroll
                    for (int j = 0; j < 2; ++j) { const float g = g2[j];
                        const float t1 = fr == 15 ? prev[k + j] : g, t2 = fr >= 14 ? prev[k + j] : g;
                        int o1, o2; asm volatile("" : "=v"(o1), "=v"(o2));
                        p1v[j] = __int_as_float(__builtin_amdgcn_update_dpp(o1, __float_as_int(t1), 0x121, 0xf, 0xf, false));
                        p2v[j] = __int_as_float(__builtin_amdgcn_update_dpp(o2, __float_as_int(t2), 0x122, 0xf, 0xf, false));
                        prev[k + j] = g; }
                    const f32x2p c0 = {cw0[k], cw0[k + 1]}, c1 = {cw1[k], cw1[k + 1]}, c2 = {cw2[k], cw2[k + 1]}, cbv = {cb[k], cb[k + 1]};
                    const f32x2p gc = __builtin_elementwise_fma(c2, g2, __builtin_elementwise_fma(c1, p1v, __builtin_elementwise_fma(c0, p2v, cbv)));
                    const f32x2p ex = gc * -1.4426950408889634f; f32x2p den; den[0] = __builtin_amdgcn_exp2f(ex[0]); den[1] = __builtin_amdgcn_exp2f(ex[1]); den = den + 1.0f;
                    f32x2p rc; rc[0] = __builtin_amdgcn_rcpf(den[0]); rc[1] = __builtin_amdgcn_rcpf(den[1]);
                    const f32x2p av = (gc * u2) * rc; a[k] = av[0]; a[k + 1] = av[1]; }
                if (!(ai == 0 && wr == 0 && m == 0 && fr < 2)) { u32x4 w; w.x = cvt_pk_bf16(a[0], a[1]); w.y = cvt_pk_bf16(a[2], a[3]); w.z = cvt_pk_bf16(a[4], a[5]); w.w = cvt_pk_bf16(a[6], a[7]);
                    *(u32x4*)(ACT + ((size_t)(f0 >> 6) * 16896 + (row0 + ai * HALF + m * 16)) * 64 + (f0 & 63)) = w; }
            }
        }
    }
};
struct EpiDown {
    static constexpr bool PERM = true, AFTER_DRAIN = false;
    float* out; int ntk; const bf16_t* hb; float* part;
    __device__ __forceinline__ void operator()(const f32x4 (&acc)[2][2][4][2], const Unit& u, int wr, int wc, int fr, int fq) const {
        const int row0 = u.pm * BM + wr * 64 + fr; const int col0 = u.pn * BM + wc * 32 + 8 * fq;
        if (u.nt == ntk) {
#pragma unroll
        for (int ai = 0; ai < 2; ++ai) {
            u32x4 pre[4][2];
#pragma unroll
            for (int m = 0; m < 4; ++m) { const size_t off = (size_t)(row0 + ai * HALF + m * 16) * 2048 + col0;
#pragma unroll
                for (int bj = 0; bj < 2; ++bj) pre[m][bj] = __builtin_nontemporal_load((const u32x4*)(hb + off + bj * HALF)); }
#pragma unroll
            for (int m = 0; m < 4; ++m) { const size_t off = (size_t)(row0 + ai * HALF + m * 16) * 2048 + col0;
#pragma unroll
                for (int bj = 0; bj < 2; ++bj) { const u32x4 p = pre[m][bj];
                    const f32x4 h0 = {__uint_as_float(p.x << 16), __uint_as_float(p.x & 0xffff0000u), __uint_as_float(p.y << 16), __uint_as_float(p.y & 0xffff0000u)};
                    const f32x4 h1 = {__uint_as_float(p.z << 16), __uint_as_float(p.z & 0xffff0000u), __uint_as_float(p.w << 16), __uint_as_float(p.w & 0xffff0000u)};
                    *(f32x4*)(out + off + bj * HALF) = h0 + acc[ai][bj][m][0]; *(f32x4*)(out + off + bj * HALF + 4) = h1 + acc[ai][bj][m][1]; } }
        }
        } else {
            float* pp = part + (size_t)(u.kt0 / u.nt) * (512 * 2048);
#pragma unroll
        for (int ai = 0; ai < 2; ++ai)
#pragma unroll
            for (int m = 0; m < 4; ++m) { const size_t off = (size_t)(row0 + ai * HALF + m * 16 - MROWS_PROMPT) * 2048 + col0;
#pragma unroll
                for (int bj = 0; bj < 2; ++bj) { *(f32x4*)(pp + off + bj * HALF) = acc[ai][bj][m][0]; *(f32x4*)(pp + off + bj * HALF + 4) = acc[ai][bj][m][1]; } }
        }
    }
};
template <class Epi, class Sched, bool ALIGN_EPI = false, bool SP2 = false>
__device__ __forceinline__ void gemm_phase(PG8_LAS unsigned char* lds, const Gemm g, const Sched& S, const Epi& E) {
    const int tid = threadIdx.x, wid = __builtin_amdgcn_readfirstlane(tid >> 6), lane = tid & 63, wr = wid >> 2, wc = wid & 3, fr = lane & 15, fq = lane >> 4;
    const int K = g.K;
    unsigned voffA[2], voffB[2];
#pragma unroll
    for (int i = 0; i < 2; ++i) { int R, C; stage_rc(tid * 16 + i * 8192, R, C); const int Rb = Epi::PERM ? ((R & ~31) + perm32(R & 31)) : R;
        voffA[i] = (unsigned)(R * (g.a_ktm ? BK : K) + C) * 2u; voffB[i] = (unsigned)(Rb * K + C) * 2u; }
    const size_t kstep = (size_t)(BK * 2);
    const size_t hstep = (size_t)HALF * K * 2;
    const size_t tstep = 2 * hstep;
    const size_t kstepA = g.a_ktm ? (size_t)g.M * BK * 2 : kstep, hstepA = g.a_ktm ? (size_t)HALF * BK * 2 : hstep, tstepA = 2 * hstepA;
    const unsigned ldsw = (unsigned)wid * 1024u;
    const int aoff = lds_byte(wr * 64 + fr, fq * 8), boff = lds_byte(wc * 32 + fr, fq * 8);
#define PG8_SA(b, h) (((b) * 2 + (h)) * HTB)
#define PG8_SB(b, h) ((4 + (b) * 2 + (h)) * HTB)
#define PG8_STAGE(bufoff, gbase, voff) do { _Pragma("unroll") for (int _i = 0; _i < 2; ++_i) \
        __builtin_amdgcn_global_load_lds((const unsigned*)((const char*)(gbase) + (voff)[_i]), (PG8_LAS unsigned*)(lds + (bufoff) + ldsw + _i * 8192), 16, 0, 0); } while (0)
#define PG8_LDA(dst, b, h) do { _Pragma("unroll") for (int m = 0; m < 4; ++m) _Pragma("unroll") for (int k = 0; k < 2; ++k) dst[m][k] = *(const PG8_LAS bf16x8*)(lds + PG8_SA(b, h) + aoff + m * 2048 + k * 1024); } while (0)
#define PG8_LDB(dst, b, h) do { _Pragma("unroll") for (int n = 0; n < 2; ++n) _Pragma("unroll") for (int k = 0; k < 2; ++k) dst[n][k] = *(const PG8_LAS bf16x8*)(lds + PG8_SB(b, h) + boff + n * 2048 + k * 1024); } while (0)
#define PG8_MMA(ai, bj, At, Bt) do { __builtin_amdgcn_s_setprio(1); _Pragma("unroll") for (int m = 0; m < 4; ++m) _Pragma("unroll") for (int n = 0; n < 2; ++n) _Pragma("unroll") for (int k = 0; k < 2; ++k) \
        acc[ai][bj][m][n] = __builtin_amdgcn_mfma_f32_16x16x32_bf16(Bt[n][k], At[m][k], acc[ai][bj][m][n], 0, 0, 0); __builtin_amdgcn_s_setprio(0); } while (0)
#define PG8_WAIT_V(n) asm volatile("s_waitcnt vmcnt(" #n ")" ::: "memory")
#define PG8_WAIT_L(n) asm volatile("s_waitcnt lgkmcnt(" #n ")" ::: "memory")
#define PG8_BAR __builtin_amdgcn_s_barrier()
#define PG8_SCHED __builtin_amdgcn_sched_barrier(0)
    Unit cur, nxt; int ui = 0;
    if (!S.next(0, cur)) return;
    f32x4 acc[2][2][4][2];
#pragma unroll
    for (int a = 0; a < 2; ++a)
#pragma unroll
        for (int b = 0; b < 2; ++b)
#pragma unroll
            for (int m = 0; m < 4; ++m)
#pragma unroll
                for (int n = 0; n < 2; ++n) acc[a][b][m][n] = (f32x4){0.f, 0.f, 0.f, 0.f};
    bf16x8 At[4][2], B0[2][2], B1[2][2];
    const char* cA = (const char*)g.A + (size_t)cur.pm * tstepA + (size_t)cur.kt0 * kstepA; const char* cB = (const char*)g.Bt + (size_t)cur.pn * tstep + (size_t)cur.kt0 * kstep;
    S.a_ready(cur);
    if constexpr (SP2) {
        PG8_STAGE(PG8_SB(0, 0), cB, voffB); PG8_STAGE(PG8_SB(0, 1), cB + hstep, voffB); PG8_STAGE(PG8_SA(0, 0), cA, voffA); PG8_STAGE(PG8_SA(0, 1), cA + hstepA, voffA);
        if (wr == 1) PG8_BAR;
        PG8_WAIT_V(2); PG8_BAR;
        PG8_STAGE(PG8_SB(1, 0), cB + kstep, voffB); PG8_STAGE(PG8_SA(1, 0), cA + kstepA, voffA); PG8_STAGE(PG8_SB(1, 1), cB + hstep + kstep, voffB);
        PG8_WAIT_V(6); PG8_BAR;
    } else {
        PG8_STAGE(PG8_SB(0, 0), cB, voffB); PG8_STAGE(PG8_SA(0, 0), cA, voffA); PG8_STAGE(PG8_SB(0, 1), cB + hstep, voffB); PG8_STAGE(PG8_SA(0, 1), cA + hstepA, voffA);
        if (wr == 1) PG8_BAR;
        PG8_WAIT_V(4); PG8_BAR;
        PG8_STAGE(PG8_SB(1, 0), cB + kstep, voffB); PG8_STAGE(PG8_SA(1, 0), cA + kstepA, voffA); PG8_STAGE(PG8_SB(1, 1), cB + hstep + kstep, voffB);
        PG8_WAIT_V(6); PG8_BAR;
    }
    for (;;) {
        const bool has_next = S.next(ui + 1, nxt);
        const char* nA = has_next ? (const char*)g.A + (size_t)nxt.pm * tstepA + (size_t)nxt.kt0 * kstepA : cA; const char* nB = has_next ? (const char*)g.Bt + (size_t)nxt.pn * tstep + (size_t)nxt.kt0 * kstep : cB;
        const int nt = cur.nt;
        for (int t = 0; t < nt; t += 2) {
            const bool last = (t == nt - 2);
            const char* a1 = cA + (size_t)(t + 1) * kstepA;
            const char* a2 = last ? nA : cA + (size_t)(t + 2) * kstepA; const char* b2 = last ? nB : cB + (size_t)(t + 2) * kstep;
            const char* a3 = a2 + kstepA; const char* b3 = b2 + kstep;
            if (last && has_next) S.a_ready(nxt);
            if constexpr (SP2) {
            PG8_LDB(B0, 0, 0); PG8_LDB(B1, 0, 1); PG8_SCHED; PG8_LDA(At, 0, 0); PG8_STAGE(PG8_SA(1, 1), a1 + hstepA, voffA);
            PG8_WAIT_V(8); PG8_WAIT_L(0); PG8_BAR; PG8_MMA(0, 0, At, B0); PG8_MMA(0, 1, At, B1); PG8_BAR; PG8_SCHED;
            PG8_LDA(At, 0, 1); PG8_STAGE(PG8_SB(0, 0), b2, voffB); PG8_STAGE(PG8_SB(0, 1), b2 + hstep, voffB); PG8_STAGE(PG8_SA(0, 0), a2, voffA);
            PG8_WAIT_V(8); PG8_WAIT_L(0); PG8_BAR; PG8_MMA(1, 0, At, B0); PG8_MMA(1, 1, At, B1); PG8_BAR; PG8_SCHED;
            PG8_LDB(B0, 1, 0); PG8_LDB(B1, 1, 1); PG8_SCHED; PG8_LDA(At, 1, 0); PG8_STAGE(PG8_SA(0, 1), a2 + hstepA, voffA);
            PG8_WAIT_V(8); PG8_WAIT_L(0); PG8_BAR; PG8_MMA(0, 0, At, B0); PG8_MMA(0, 1, At, B1); PG8_BAR; PG8_SCHED;
            PG8_LDA(At, 1, 1); PG8_STAGE(PG8_SB(1, 0), b3, voffB); PG8_STAGE(PG8_SB(1, 1), b3 + hstep, voffB); PG8_STAGE(PG8_SA(1, 0), a3, voffA);
            PG8_WAIT_V(8); PG8_WAIT_L(0); PG8_BAR; PG8_MMA(1, 0, At, B0); PG8_MMA(1, 1, At, B1); PG8_BAR; PG8_SCHED;
            } else {
            PG8_LDB(B0, 0, 0); PG8_SCHED; PG8_LDA(At, 0, 0); PG8_STAGE(PG8_SA(1, 1), a1 + hstepA, voffA);
            PG8_WAIT_L(8); PG8_BAR; PG8_WAIT_L(0); PG8_MMA(0, 0, At, B0); PG8_BAR; PG8_SCHED;
            PG8_LDB(B1, 0, 1); PG8_STAGE(PG8_SB(0, 0), b2, voffB);
            PG8_BAR; PG8_WAIT_L(0); PG8_MMA(0, 1, At, B1); PG8_BAR;
            PG8_LDA(At, 0, 1); PG8_STAGE(PG8_SA(0, 0), a2, voffA);
            PG8_BAR; PG8_WAIT_L(0); PG8_MMA(1, 0, At, B0); PG8_BAR; PG8_SCHED;
            PG8_STAGE(PG8_SB(0, 1), b2 + hstep, voffB);
            PG8_WAIT_V(6); PG8_BAR; PG8_MMA(1, 1, At, B1); PG8_BAR;
            PG8_LDB(B0, 1, 0); PG8_SCHED; PG8_LDA(At, 1, 0); PG8_STAGE(PG8_SA(0, 1), a2 + hstepA, voffA);
            PG8_WAIT_L(8); PG8_BAR; PG8_WAIT_L(0); PG8_MMA(0, 0, At, B0); PG8_BAR; PG8_SCHED;
            PG8_LDB(B1, 1, 1); PG8_STAGE(PG8_SB(1, 0), b3, voffB);
            PG8_BAR; PG8_WAIT_L(0); PG8_MMA(0, 1, At, B1); PG8_BAR;
            PG8_LDA(At, 1, 1); PG8_STAGE(PG8_SA(1, 0), a3, voffA);
            PG8_BAR; PG8_WAIT_L(0); PG8_MMA(1, 0, At, B0); PG8_BAR; PG8_SCHED;
            PG8_STAGE(PG8_SB(1, 1), b3 + hstep, voffB);
            PG8_WAIT_V(6); PG8_BAR; PG8_MMA(1, 1, At, B1); PG8_BAR;
            }
        }
        if constexpr (ALIGN_EPI) { if (wr == 0) PG8_BAR; }
        if constexpr (!Epi::AFTER_DRAIN) { E(acc, cur, wr, wc, fr, fq); S.done(cur); }
        if (!has_next) break;
#pragma unroll
        for (int a = 0; a < 2; ++a)
#pragma unroll
            for (int b = 0; b < 2; ++b)
#pragma unroll
                for (int m = 0; m < 4; ++m)
#pragma unroll
                    for (int n = 0; n < 2; ++n) acc[a][b][m][n] = (f32x4){0.f, 0.f, 0.f, 0.f};
        cur = nxt; cA = nA; cB = nB; ++ui;
        if constexpr (ALIGN_EPI) { if (wr == 1) PG8_BAR; }
    }
    PG8_WAIT_V(0);
    if constexpr (!ALIGN_EPI) { if (wr == 0) PG8_BAR; }
    PG8_BAR;
    if constexpr (Epi::AFTER_DRAIN) { E.fused(acc, cur, wr, wc, fr, fq, lds, wid, lane); S.done(cur); }
#undef PG8_SA
#undef PG8_SB
#undef PG8_STAGE
#undef PG8_LDA
#undef PG8_LDB
#undef PG8_MMA
#undef PG8_WAIT_V
#undef PG8_WAIT_L
#undef PG8_BAR
#undef PG8_SCHED
}
}

#ifndef MK_N_LAUNCHES
#define MK_N_LAUNCHES 1
#endif
#ifndef PROBE_SEQ
#define PROBE_SEQ {0, 1, 2, 3, 4, 5, 6, 7, 8, 9, 10}
#endif
#define DI __device__ __forceinline__
#define LAS __attribute__((address_space(3)))
typedef unsigned short bf16;
typedef short bf16x8 __attribute__((ext_vector_type(8)));
typedef float f32x4 __attribute__((ext_vector_type(4)));
typedef float f32x2 __attribute__((ext_vector_type(2)));
typedef unsigned u32x4 __attribute__((ext_vector_type(4)));
typedef unsigned u32x2 __attribute__((ext_vector_type(2)));

constexpr int NPH = 11;
constexpr int MP = 16384, MS = 512, MT = 16896, DM = 2048, PW = 4352, DFF = 5632;
constexpr float LOG2E = 1.4426950408889634f;
constexpr size_t MiB = 1u << 20;
constexpr size_t WS_TABC = 1 * MiB, WS_TABS = 2 * MiB, WS_SSQ = 3 * MiB;
constexpr size_t WS_WUP = 4 * MiB, WS_WDN = 48 * MiB, WS_HB = 70 * MiB;
constexpr size_t WS_G = 136 * MiB, WS_U = WS_G + (size_t)MT * DFF * 2, WS_END = WS_U + (size_t)MT * DFF * 2;
constexpr size_t WS_WIN = 136 * MiB, WS_WO = 153 * MiB, WS_PROJ = 161 * MiB, WS_CAT = 302 * MiB, WS_LBUF = 368 * MiB, WS_SBUF = 400 * MiB;
static_assert(WS_PROJ + (size_t)MT * PW * 2 <= WS_CAT && WS_SBUF + 16 * MiB <= WS_END, "ws map");
constexpr size_t WS_PART = 161 * MiB;
constexpr int KSPLIT = 11;
constexpr size_t WS_GSB = 136 * MiB, WS_USB = 142 * MiB, WS_GHF = 148 * MiB, WS_UHF = 151 * MiB, WS_GHL = 154 * MiB;
constexpr size_t OFF_Y = 0, OFF_RET_P = (size_t)MT * DM, OFF_RET_S = OFF_RET_P + 262144, OFF_SWAK_P = OFF_RET_S + 8388608, OFF_SWAK_S = OFF_SWAK_P + 65536,
                 OFF_SWAV_P = OFF_SWAK_S + 2097152, OFF_SWAV_S = OFF_SWAV_P + 65536, OFF_CONV_P = OFF_SWAV_S + 2097152, OFF_CONV_S = OFF_CONV_P + 45056, OUT_TOTAL = OFF_CONV_S + 1441792;
constexpr int LDS_BYTES = 147456;

struct Params {
    const float *x_prompt, *x_sample, *state_ret, *cache_k, *cache_v, *state_conv, *attn_norm_w, *w_in, *q_norm_w, *k_norm_w, *sinks, *gn_w, *w_o, *ffn_norm_w, *w_up, *conv_w, *conv_b, *w_down;
    float* out; unsigned char* ws;
    float inv_freq[32]; float lg2[8];
    int ph_lo, ph_hi, dummy, pad;
};

DI float bf_lo(unsigned v) { return __uint_as_float(v << 16); }
DI float bf_hi(unsigned v) { return __uint_as_float(v & 0xffff0000u); }
DI unsigned pk2(float lo, float hi) { return pg8::cvt_pk_bf16(lo, hi); }
DI unsigned short f2bf(float f) { return (unsigned short)(pk2(f, f) & 0xffffu); }
DI void unpack8(const u32x4 v, float (&f)[8]) { f[0] = bf_lo(v.x); f[1] = bf_hi(v.x); f[2] = bf_lo(v.y); f[3] = bf_hi(v.y); f[4] = bf_lo(v.z); f[5] = bf_hi(v.z); f[6] = bf_lo(v.w); f[7] = bf_hi(v.w); }
DI u32x4 pack8(const float (&f)[8]) { u32x4 r; r.x = pk2(f[0], f[1]); r.y = pk2(f[2], f[3]); r.z = pk2(f[4], f[5]); r.w = pk2(f[6], f[7]); return r; }
DI bf16x8 as_bf16x8(u32x4 v) { return __builtin_bit_cast(bf16x8, v); }
DI float wave_sum(float v) {
#pragma unroll
    for (int o = 1; o < 64; o <<= 1) v += __shfl_xor(v, o);
    return v;
}
DI f32x4 mfma16(bf16x8 a, bf16x8 b, f32x4 c) { return __builtin_amdgcn_mfma_f32_16x16x32_bf16(a, b, c, 0, 0, 0); }
DI float ex2(float x) { return __builtin_amdgcn_exp2f(x); }
DI float silu(float x) { return x * __builtin_amdgcn_rcpf(1.0f + __expf(-x)); }
DI float sel_lg2(const Params& P, int h) { float r = P.lg2[0];
#pragma unroll
    for (int k = 1; k < 8; ++k) r = (h == k) ? P.lg2[k] : r;
    return r; }
#define LDS_WAIT() asm volatile("s_waitcnt lgkmcnt(0)" ::: "memory")

DI void p0_transpose_item(const float* W, int K, int N, bf16* WT, LAS float* scr, int item, int lane, const float* kscale, bool upmap) {
    const int nblk = N / 32, kb = item / nblk, nb = item % nblk, k0 = 64 * kb, n0 = 32 * nb;
    const int r0 = !upmap ? n0 : (n0 < DFF ? (n0 / 128) * 256 + (n0 % 128) : ((n0 - DFF) / 128) * 256 + 128 + ((n0 - DFF) % 128));
    f32x4 v[8];
#pragma unroll
    for (int i = 0; i < 8; ++i) { const int kk = 8 * i + (lane >> 3); v[i] = __builtin_nontemporal_load((const f32x4*)(W + (size_t)(k0 + kk) * N + n0 + 4 * (lane & 7))); }
#pragma unroll
    for (int i = 0; i < 8; ++i) { const int kk = 8 * i + (lane >> 3); f32x4 t = v[i]; if (kscale) t = t * kscale[k0 + kk]; LAS float* d = scr + kk * 33 + 4 * (lane & 7); d[0] = t[0]; d[1] = t[1]; d[2] = t[2]; d[3] = t[3]; }
    LDS_WAIT();
    const int c = lane & 7;
#pragma unroll
    for (int j = 0; j < 4; ++j) { const int n = (lane >> 3) + 8 * j; const LAS float* s = scr + (8 * c) * 33 + n;
        u32x4 o; o.x = pk2(s[0 * 33], s[1 * 33]); o.y = pk2(s[2 * 33], s[3 * 33]); o.z = pk2(s[4 * 33], s[5 * 33]); o.w = pk2(s[6 * 33], s[7 * 33]);
        *(u32x4*)(WT + (size_t)(r0 + n) * K + k0 + 8 * c) = o; }
    LDS_WAIT();
}
DI void rms_row_to_bf16(const float* xrow, const float* w, bf16* orow, int lane) {
    const f32x4* xr = (const f32x4*)xrow + lane; const f32x4* wr = (const f32x4*)w + lane;
    f32x4 v[8]; float s = 0.f;
#pragma unroll
    for (int j = 0; j < 8; ++j) { v[j] = xr[64 * j]; s += (v[j].x * v[j].x + v[j].y * v[j].y) + (v[j].z * v[j].z + v[j].w * v[j].w); }
    const float rstd = 1.0f / sqrtf(wave_sum(s) * (1.0f / 2048.0f) + 1e-6f);
#pragma unroll
    for (int j = 0; j < 8; ++j) { const f32x4 ww = wr[64 * j]; const f32x4 o = v[j] * rstd * ww; u32x2 pk; pk.x = pk2(o.x, o.y); pk.y = pk2(o.z, o.w); *(u32x2*)(orow + 4 * lane + 256 * j) = pk; }
}
DI void p0_prologue(const Params& P, LAS unsigned char* lds, int tid, int lane, int w) {
    LAS float* scr = (LAS float*)(lds + w * 16384);
    const int gw = blockIdx.x * 8 + w, NGW = gridDim.x * 8;
    bf16* wt_in = (bf16*)(P.ws + WS_WIN); bf16* wt_o = (bf16*)(P.ws + WS_WO);
    constexpr int I_IN = (DM / 64) * (PW / 32), I_O = (DM / 64) * (DM / 32);
    constexpr int NITEMS = I_IN + I_O;
    for (int it = gw; it < NITEMS; it += NGW) {
        if (it < I_IN) p0_transpose_item(P.w_in, DM, PW, wt_in, scr, it, lane, nullptr, false);
        else p0_transpose_item(P.w_o, DM, DM, wt_o, scr, it - I_IN, lane, nullptr, false);
    }
    bf16* a1 = (bf16*)(P.ws + WS_HB);
    for (int m = gw; m < MT; m += 2 * NGW) {
        const int m2 = m + NGW; const bool has2 = m2 < MT; const int mb = has2 ? m2 : m;
        const f32x4* xa = (const f32x4*)(m < MP ? P.x_prompt + (size_t)m * DM : P.x_sample + (size_t)(m - MP) * DM) + lane;
        const f32x4* xb = (const f32x4*)(mb < MP ? P.x_prompt + (size_t)mb * DM : P.x_sample + (size_t)(mb - MP) * DM) + lane;
        const f32x4* wr = (const f32x4*)P.attn_norm_w + lane;
        f32x4 va[8], vb[8]; float sa = 0.f, sb = 0.f;
#pragma unroll
        for (int j = 0; j < 8; ++j) { va[j] = __builtin_nontemporal_load(xa + 64 * j); vb[j] = __builtin_nontemporal_load(xb + 64 * j); }
#pragma unroll
        for (int j = 0; j < 8; ++j) { sa += (va[j].x * va[j].x + va[j].y * va[j].y) + (va[j].z * va[j].z + va[j].w * va[j].w); sb += (vb[j].x * vb[j].x + vb[j].y * vb[j].y) + (vb[j].z * vb[j].z + vb[j].w * vb[j].w); }
        const float ra = 1.0f / sqrtf(wave_sum(sa) * (1.0f / 2048.0f) + 1e-6f), rb = 1.0f / sqrtf(wave_sum(sb) * (1.0f / 2048.0f) + 1e-6f);
#pragma unroll
        for (int j = 0; j < 8; ++j) { const f32x4 ww = wr[64 * j]; const f32x4 oa = va[j] * ra * ww, ob = vb[j] * rb * ww; u32x2 pa, pb; pa.x = pk2(oa.x, oa.y); pa.y = pk2(oa.z, oa.w); pb.x = pk2(ob.x, ob.y); pb.y = pk2(ob.z, ob.w);
            *(u32x2*)(a1 + (size_t)m * DM + 4 * lane + 256 * j) = pa; if (has2) *(u32x2*)(a1 + (size_t)m2 * DM + 4 * lane + 256 * j) = pb; }
    }
    float* tabc = (float*)(P.ws + WS_TABC); float* tabs = (float*)(P.ws + WS_TABS); float* ssq = (float*)(P.ws + WS_SSQ);
    const int gt = blockIdx.x * 512 + tid, NGT = gridDim.x * 512;
    for (int idx = gt; idx < 4100 * 32; idx += NGT) { const int p = idx >> 5, i = idx & 31; const int pos = p < 4096 ? p : 16384 + (p - 4096);
        float inv = P.inv_freq[0];
#pragma unroll
        for (int k = 1; k < 32; ++k) inv = (i == k) ? P.inv_freq[k] : inv;
        const float ang = (float)pos * inv; const double rev = (double)ang * 0.15915494309189535; const float fr = (float)(rev - floor(rev));
        tabc[idx] = __builtin_amdgcn_cosf(fr); tabs[idx] = __builtin_amdgcn_sinf(fr); }
    for (int idx = gt; idx < MT; idx += NGT) ssq[idx] = 0.f;
}

struct RopeIn { u32x4 a, c; f32x4 c0, c1, s0, s1; };
DI RopeIn rope_load(const bf16* proj, const float* tabc, const float* tabs, size_t row, int tok, int col0, int qq, bool nt = false) {
    RopeIn in; const bf16* p = proj + row * PW + col0 + 8 * qq;
    if (nt) { in.a = __builtin_nontemporal_load((const u32x4*)p); in.c = __builtin_nontemporal_load((const u32x4*)(p + 32)); } else { in.a = *(const u32x4*)p; in.c = *(const u32x4*)(p + 32); }
    const float* tc = tabc + tok * 32 + 8 * qq; const float* ts = tabs + tok * 32 + 8 * qq;
    in.c0 = *(const f32x4*)tc; in.c1 = *(const f32x4*)(tc + 4); in.s0 = *(const f32x4*)ts; in.s1 = *(const f32x4*)(ts + 4); return in;
}
DI void rope_apply(const RopeIn& in, float scale, float (&o1)[8], float (&o2)[8]) {
    float x1[8], x2[8]; unpack8(in.a, x1); unpack8(in.c, x2);
#pragma unroll
    for (int e = 0; e < 8; ++e) { const float c = e < 4 ? in.c0[e & 3] : in.c1[e & 3], s = e < 4 ? in.s0[e & 3] : in.s1[e & 3]; o1[e] = (x1[e] * c - x2[e] * s) * scale; o2[e] = (x2[e] * c + x1[e] * s) * scale; }
}

DI void tail_transposes(const Params& P, LAS unsigned char* lds, int nunits, int slot, int lane, int w) {
    const int G = gridDim.x, rem = nunits % G; const int first = rem, nidle = G - rem;
    if ((int)blockIdx.x < first) return;
    LAS float* scr = (LAS float*)(lds + w * 16384);
    const int gw = ((int)blockIdx.x - first) * 8 + w, NGW = nidle * 8;
    bf16* wt_up = (bf16*)(P.ws + WS_WUP); bf16* wt_dn = (bf16*)(P.ws + WS_WDN);
    constexpr int I_UP = (DM / 64) * (2 * DFF / 32), I_DN = (DFF / 64) * (DM / 32), I_UP_A = 8000;
    if (slot == 0) { for (int it = gw; it < I_UP_A; it += NGW) p0_transpose_item(P.w_up, DM, 2 * DFF, wt_up, scr, it, lane, P.ffn_norm_w, true); }
    else if (slot == 1) { for (int it = gw; it < I_UP - I_UP_A; it += NGW) p0_transpose_item(P.w_up, DM, 2 * DFF, wt_up, scr, I_UP_A + it, lane, P.ffn_norm_w, true); }
    else { for (int it = gw; it < I_DN; it += NGW) p0_transpose_item(P.w_down, DFF, DM, wt_dn, scr, it, lane, nullptr, false); }
}

DI void swa_prompt_unit(const Params& P, LAS unsigned char* lds, int unit, int tid, int lane, int w) {
    const bf16* proj = (const bf16*)(P.ws + WS_PROJ); const float* tabc = (const float*)(P.ws + WS_TABC); const float* tabs = (const float*)(P.ws + WS_TABS); bf16* cat = (bf16*)(P.ws + WS_CAT);
    const int qb = unit & 31, kvh = (unit >> 5) & 1, b = unit >> 6;
    LAS unsigned char* KS = lds;
    LAS unsigned char* VT = lds + 36864;
    const int l15 = lane & 15, quad = lane >> 4; const int hh = kvh * 8 + w;
    {
        const int key = tid >> 1, half = tid & 1; const int tok = 128 * (qb - 1) + key;
        float o1a[8], o1b[8], o2a[8], o2b[8]; u32x4 vr[4];
        if (tok >= 0) {
            const size_t row = (size_t)b * 4096 + tok; const bf16* p = proj + row * PW + 4096 + kvh * 64 + 16 * half;
            const u32x4 a0 = *(const u32x4*)p, a1 = *(const u32x4*)(p + 8), b0 = *(const u32x4*)(p + 32), b1 = *(const u32x4*)(p + 40);
            float x1a[8], x1b[8], x2a[8], x2b[8]; unpack8(a0, x1a); unpack8(a1, x1b); unpack8(b0, x2a); unpack8(b1, x2b);
            float ss = 0.f;
#pragma unroll
            for (int e = 0; e < 8; ++e) ss += x1a[e] * x1a[e] + x1b[e] * x1b[e] + x2a[e] * x2a[e] + x2b[e] * x2b[e];
            ss += __shfl_xor(ss, 1);
            const float rstd = 1.0f / sqrtf(ss * (1.0f / 64.0f) + 1e-6f);
            float kw[48], tc[16], ts[16];
#pragma unroll
            for (int k4 = 0; k4 < 4; ++k4) { const f32x4 a = *(const f32x4*)(P.k_norm_w + 16 * half + 4 * k4), b2 = *(const f32x4*)(P.k_norm_w + 32 + 16 * half + 4 * k4), c4 = *(const f32x4*)(tabc + tok * 32 + 16 * half + 4 * k4), s4 = *(const f32x4*)(tabs + tok * 32 + 16 * half + 4 * k4);
#pragma unroll
                for (int e = 0; e < 4; ++e) { kw[4 * k4 + e] = a[e]; kw[32 + 4 * k4 + e] = b2[e]; tc[4 * k4 + e] = c4[e]; ts[4 * k4 + e] = s4[e]; } }
#pragma unroll
            for (int e = 0; e < 8; ++e) {
                { const float n1 = x1a[e] * rstd * kw[e], n2 = x2a[e] * rstd * kw[32 + e], c = tc[e], s = ts[e]; o1a[e] = n1 * c - n2 * s; o2a[e] = n2 * c + n1 * s; }
                { const float n1 = x1b[e] * rstd * kw[8 + e], n2 = x2b[e] * rstd * kw[40 + e], c = tc[8 + e], s = ts[8 + e]; o1b[e] = n1 * c - n2 * s; o2b[e] = n2 * c + n1 * s; } }
            const bf16* pv = proj + row * PW + 4224 + kvh * 64 + 32 * half;
#pragma unroll
            for (int k = 0; k < 4; ++k) vr[k] = *(const u32x4*)(pv + 8 * k);
            if (qb == 31 && key >= 128) {
                float* ok = P.out + OFF_SWAK_P + ((size_t)(b * 128 + key - 128) * 2 + kvh) * 64; float* ov = P.out + OFF_SWAV_P + ((size_t)(b * 128 + key - 128) * 2 + kvh) * 64;
#pragma unroll
                for (int e = 0; e < 8; ++e) { ok[16 * half + e] = o1a[e]; ok[16 * half + 8 + e] = o1b[e]; ok[32 + 16 * half + e] = o2a[e]; ok[32 + 16 * half + 8 + e] = o2b[e]; }
#pragma unroll
                for (int k = 0; k < 4; ++k) { float f[8]; unpack8(vr[k], f);
#pragma unroll
                    for (int e = 0; e < 8; ++e) ov[32 * half + 8 * k + e] = f[e]; }
            }
        } else {
#pragma unroll
            for (int e = 0; e < 8; ++e) { o1a[e] = 0.f; o1b[e] = 0.f; o2a[e] = 0.f; o2b[e] = 0.f; }
#pragma unroll
            for (int k = 0; k < 4; ++k) vr[k] = (u32x4){0u, 0u, 0u, 0u};
        }
        LAS unsigned char* kp = KS + key * 144 + half * 32;
        *(LAS u32x4*)(kp) = pack8(o1a); *(LAS u32x4*)(kp + 16) = pack8(o1b); *(LAS u32x4*)(kp + 64) = pack8(o2a); *(LAS u32x4*)(kp + 80) = pack8(o2b);
#pragma unroll
        for (int k = 0; k < 4; ++k) { const unsigned wv[4] = {vr[k].x, vr[k].y, vr[k].z, vr[k].w};
#pragma unroll
            for (int e = 0; e < 4; ++e) { const int d = 32 * half + 8 * k + 2 * e;
                *(LAS unsigned short*)(VT + d * 544 + key * 2) = (unsigned short)(wv[e] & 0xffffu); *(LAS unsigned short*)(VT + (d + 1) * 544 + key * 2) = (unsigned short)(wv[e] >> 16); } }
    }
    RopeIn qnext = rope_load(proj, tabc, tabs, (size_t)b * 4096 + 128 * qb + l15, 128 * qb + l15, 3072 + hh * 64, quad);
    float qw1[8], qw2[8];
    { const f32x4 a0 = *(const f32x4*)(P.q_norm_w + 8 * quad), a1 = *(const f32x4*)(P.q_norm_w + 8 * quad + 4), b0 = *(const f32x4*)(P.q_norm_w + 32 + 8 * quad), b1 = *(const f32x4*)(P.q_norm_w + 36 + 8 * quad);
#pragma unroll
      for (int e = 0; e < 4; ++e) { qw1[e] = a0[e]; qw1[4 + e] = a1[e]; qw2[e] = b0[e]; qw2[4 + e] = b1[e]; } }
    __syncthreads();
    {
        const float sink2 = P.sinks[hh] * LOG2E; const float qscale = 0.125f * LOG2E;
#pragma unroll 2
        for (int qt = 0; qt < 8; ++qt) {
            const int i = 16 * qt + l15; const int tok = 128 * qb + i; const size_t row = (size_t)b * 4096 + tok;
            const RopeIn qin = qnext;
            if (qt < 7) qnext = rope_load(proj, tabc, tabs, row + 16, tok + 16, 3072 + hh * 64, quad);
            float x1[8], x2[8], o1[8], o2[8]; unpack8(qin.a, x1); unpack8(qin.c, x2);
            float ss = 0.f;
#pragma unroll
            for (int e = 0; e < 8; ++e) ss += x1[e] * x1[e] + x2[e] * x2[e];
            ss += __shfl_xor(ss, 16); ss += __shfl_xor(ss, 32);
            const float rstd = qscale / sqrtf(ss * (1.0f / 64.0f) + 1e-6f);
#pragma unroll
            for (int e = 0; e < 8; ++e) { const float n1 = x1[e] * rstd * qw1[e], n2 = x2[e] * rstd * qw2[e], c = e < 4 ? qin.c0[e & 3] : qin.c1[e & 3], s = e < 4 ? qin.s0[e & 3] : qin.s1[e & 3]; o1[e] = n1 * c - n2 * s; o2[e] = n2 * c + n1 * s; }
            const bf16x8 qf0 = as_bf16x8(pack8(o1)), qf1 = as_bf16x8(pack8(o2));
            f32x4 acc[10];
#pragma unroll
            for (int tt = 0; tt < 9; ++tt) { int jt = qt + tt; jt = jt > 15 ? 15 : jt;
                const LAS unsigned char* kp = KS + (16 * jt + l15) * 144 + quad * 16;
                const bf16x8 k0 = *(const LAS bf16x8*)kp, k1 = *(const LAS bf16x8*)(kp + 64);
                f32x4 z = {0.f, 0.f, 0.f, 0.f}; z = mfma16(k0, qf0, z); acc[tt] = mfma16(k1, qf1, z); }
            acc[9] = (f32x4){0.f, 0.f, 0.f, 0.f};
            float mx = -INFINITY;
#pragma unroll
            for (int tt = 0; tt < 9; ++tt)
#pragma unroll
                for (int e = 0; e < 4; ++e) { const int kidx = 16 * (qt + tt) + 4 * quad + e; const bool valid = (kidx >= i) && (kidx <= i + 128) && (qb > 0 || kidx >= 128);
                    const float sv = valid ? acc[tt][e] : -INFINITY; acc[tt][e] = sv; mx = fmaxf(mx, sv); }
            mx = fmaxf(mx, __shfl_xor(mx, 16)); mx = fmaxf(mx, __shfl_xor(mx, 32));
            const float m = fmaxf(mx, sink2); float sum = 0.f;
#pragma unroll
            for (int tt = 0; tt < 9; ++tt)
#pragma unroll
                for (int e = 0; e < 4; ++e) { const float pe = ex2(acc[tt][e] - m); acc[tt][e] = pe; sum += pe; }
            sum += __shfl_xor(sum, 16); sum += __shfl_xor(sum, 32);
            const float inv = 1.0f / (sum + ex2(sink2 - m));
            f32x4 o[4];
#pragma unroll
            for (int dt = 0; dt < 4; ++dt) o[dt] = (f32x4){0.f, 0.f, 0.f, 0.f};
#pragma unroll
            for (int pp = 0; pp < 5; ++pp) {
                u32x4 pw; pw.x = pk2(acc[2 * pp][0], acc[2 * pp][1]); pw.y = pk2(acc[2 * pp][2], acc[2 * pp][3]); pw.z = pk2(acc[2 * pp + 1][0], acc[2 * pp + 1][1]); pw.w = pk2(acc[2 * pp + 1][2], acc[2 * pp + 1][3]);
                const bf16x8 pf = as_bf16x8(pw);
                int ja = qt + 2 * pp; ja = ja > 15 ? 15 : ja; int jb = qt + 2 * pp + 1; jb = jb > 15 ? 15 : jb;
#pragma unroll
                for (int dt = 0; dt < 4; ++dt) { const LAS unsigned char* vp = VT + (16 * dt + l15) * 544 + quad * 8;
                    const u32x2 va = *(const LAS u32x2*)(vp + ja * 32), vb = *(const LAS u32x2*)(vp + jb * 32);
                    const bf16x8 vf = as_bf16x8((u32x4){va.x, va.y, vb.x, vb.y}); o[dt] = mfma16(vf, pf, o[dt]); } }
#pragma unroll
            for (int dt = 0; dt < 4; ++dt) { bf16* op = cat + row * DM + 1024 + hh * 64 + 16 * dt + 4 * quad; u32x2 pk; pk.x = pk2(o[dt][0] * inv, o[dt][1] * inv); pk.y = pk2(o[dt][2] * inv, o[dt][3] * inv); *(u32x2*)op = pk; }
        }
    }
    __syncthreads();
}

DI void ret_stage_vt(const bf16* proj, LAS unsigned char* VT, size_t row0, int h, int tid, bool nt = false) {
    const int j = tid >> 2, qq = tid & 3; const bf16* pv = proj + (row0 + j) * PW + 1024 + h * 128 + 32 * qq;
#pragma unroll
    for (int k = 0; k < 4; ++k) { const u32x4 v = nt ? __builtin_nontemporal_load((const u32x4*)(pv + 8 * k)) : *(const u32x4*)(pv + 8 * k); const unsigned wv[4] = {v.x, v.y, v.z, v.w};
#pragma unroll
        for (int e = 0; e < 4; ++e) { const int d = 32 * qq + 8 * k + 2 * e;
            *(LAS unsigned short*)(VT + d * 272 + j * 2) = (unsigned short)(wv[e] & 0xffffu); *(LAS unsigned short*)(VT + (d + 1) * 272 + j * 2) = (unsigned short)(wv[e] >> 16); } }
}
DI void ret_rope_k(const bf16* proj, const float* tabc, const float* tabs, size_t row, int tok, int col0, int qq, float scale, float (&o1)[8], float (&o2)[8], bool nt = false) {
    const RopeIn in = rope_load(proj, tabc, tabs, row, tok, col0, qq, nt); rope_apply(in, scale, o1, o2);
}

DI void ret_l_unit(const Params& P, LAS unsigned char* lds0, int unit, int tid, int lane, int w, int buf) {
    LAS unsigned char* lds = lds0 + buf * 53248;
    const bf16* proj = (const bf16*)(P.ws + WS_PROJ); const float* tabc = (const float*)(P.ws + WS_TABC); const float* tabs = (const float*)(P.ws + WS_TABS); float* lbuf = (float*)(P.ws + WS_LBUF);
    const int c = unit & 31, h = (unit >> 5) & 7, b = unit >> 8; const float lg = sel_lg2(P, h);
    LAS unsigned char* KT = lds;
    LAS unsigned char* VT = lds + 17408;
    const size_t row0 = (size_t)b * 4096 + 128 * c;
    {
        const int j = tid >> 2, qq = tid & 3; float o1[8], o2[8];
        ret_rope_k(proj, tabc, tabs, row0 + j, 128 * c + j, 512 + h * 64, qq, 0.125f * ex2((float)(127 - j) * lg), o1, o2);
#pragma unroll
        for (int e = 0; e < 8; ++e) { *(LAS unsigned short*)(KT + (8 * qq + e) * 272 + j * 2) = f2bf(o1[e]); *(LAS unsigned short*)(KT + (32 + 8 * qq + e) * 272 + j * 2) = f2bf(o2[e]); }
        ret_stage_vt(proj, VT, row0, h, tid);
    }
    __syncthreads();
    {
        const int l15 = lane & 15, quad = lane >> 4;
        f32x4 acc[4];
#pragma unroll
        for (int kt = 0; kt < 4; ++kt) acc[kt] = (f32x4){0.f, 0.f, 0.f, 0.f};
#pragma unroll
        for (int s = 0; s < 4; ++s) { const bf16x8 vf = *(const LAS bf16x8*)(VT + (16 * w + l15) * 272 + (32 * s + 8 * quad) * 2);
#pragma unroll
            for (int kt = 0; kt < 4; ++kt) { const bf16x8 kf = *(const LAS bf16x8*)(KT + (16 * kt + l15) * 272 + (32 * s + 8 * quad) * 2); acc[kt] = mfma16(kf, vf, acc[kt]); } }
        float* lp = lbuf + (size_t)unit * 8192 + (16 * w + l15) * 64 + 4 * quad;
#pragma unroll
        for (int kt = 0; kt < 4; ++kt) *(f32x4*)(lp + 16 * kt) = acc[kt];
    }
}

DI void ret_scan(const Params& P, int tid) {
    const float* __restrict__ lbuf = (const float*)(P.ws + WS_LBUF); unsigned* __restrict__ sbuf = (unsigned*)(P.ws + WS_SBUF);
    for (int idx = blockIdx.x * 512 + tid; idx < 32 * 4096; idx += gridDim.x * 512) {
        const int bh = idx >> 12, e2 = idx & 4095; const float g128 = ex2(128.0f * sel_lg2(P, bh & 7));
        const size_t o0 = (size_t)(bh * 32) * 8192 + 2 * e2;
        f32x2 l[32];
#pragma unroll
        for (int c = 0; c < 32; ++c) l[c] = *(const f32x2*)(lbuf + o0 + (size_t)c * 8192);
        float s0 = 0.f, s1 = 0.f;
#pragma unroll
        for (int c = 0; c < 32; ++c) { sbuf[(o0 + (size_t)c * 8192) >> 1] = pk2(s0, s1); s0 = s0 * g128 + l[c].x; s1 = s1 * g128 + l[c].y; }
        const int dv = (2 * e2) >> 6, dk = (2 * e2) & 63; float* op = P.out + OFF_RET_P + ((size_t)bh * 64 + dk) * 128 + dv; op[0] = s0; op[128] = s1;
    }
}

DI void ret_c_unit(const Params& P, LAS unsigned char* lds0, int unit, int tid, int lane, int w, int buf, float (&S)[16], float g128) {
    LAS unsigned char* lds = lds0 + buf * 71680;
    LAS unsigned char* SL = lds + 53248;
    const bf16* proj = (const bf16*)(P.ws + WS_PROJ); const float* tabc = (const float*)(P.ws + WS_TABC); const float* tabs = (const float*)(P.ws + WS_TABS);
    const float* lbuf = (const float*)(P.ws + WS_LBUF); bf16* cat = (bf16*)(P.ws + WS_CAT);
    const int c = unit & 31, h = (unit >> 5) & 7, b = unit >> 8; const float lg = sel_lg2(P, h);
    LAS unsigned char* KS = lds;
    LAS unsigned char* VT = lds + 18432;
    const size_t row0 = (size_t)b * 4096 + 128 * c;
    const int l15 = lane & 15, quad = lane >> 4; const int il = 16 * w + l15; const size_t row = row0 + il;
    const RopeIn qin = rope_load(proj, tabc, tabs, row, 128 * c + il, h * 64, quad, true);
    const int sdv = tid >> 2, sdk = (tid & 3) * 16;
    {
        const int j = tid >> 2, qq = tid & 3; float o1[8], o2[8];
        ret_rope_k(proj, tabc, tabs, row0 + j, 128 * c + j, 512 + h * 64, qq, 0.125f, o1, o2, true);
        *(LAS u32x4*)(KS + j * 144 + qq * 16) = pack8(o1); *(LAS u32x4*)(KS + j * 144 + 64 + qq * 16) = pack8(o2);
        ret_stage_vt(proj, VT, row0, h, tid, true);
        { float s0[8], s1[8];
#pragma unroll
          for (int e = 0; e < 8; ++e) { s0[e] = S[e]; s1[e] = S[8 + e]; }
          *(LAS u32x4*)(SL + sdv * 144 + sdk * 2) = pack8(s0); *(LAS u32x4*)(SL + sdv * 144 + sdk * 2 + 16) = pack8(s1); }
    }
    __syncthreads();
    {
        float q1[8], q2[8]; rope_apply(qin, 1.0f, q1, q2);
        const bf16x8 qf0 = as_bf16x8(pack8(q1)), qf1 = as_bf16x8(pack8(q2));
        f32x4 acc[8];
#pragma unroll
        for (int vt = 0; vt < 8; ++vt) { const LAS unsigned char* sp = SL + (16 * vt + l15) * 144 + quad * 16; const bf16x8 s0 = *(const LAS bf16x8*)sp, s1 = *(const LAS bf16x8*)(sp + 64);
            f32x4 z = {0.f, 0.f, 0.f, 0.f}; z = mfma16(s0, qf0, z); acc[vt] = mfma16(s1, qf1, z); }
        const float rowdec = ex2((float)(il + 1) * lg);
#pragma unroll
        for (int vt = 0; vt < 8; ++vt) acc[vt] = acc[vt] * rowdec;
        f32x4 sc[8];
#pragma unroll
        for (int jt = 0; jt < 8; ++jt) {
            if (jt <= w) { const LAS unsigned char* kp = KS + (16 * jt + l15) * 144 + quad * 16; const bf16x8 k0 = *(const LAS bf16x8*)kp, k1 = *(const LAS bf16x8*)(kp + 64);
                f32x4 z = {0.f, 0.f, 0.f, 0.f}; z = mfma16(k0, qf0, z); z = mfma16(k1, qf1, z);
#pragma unroll
                for (int e = 0; e < 4; ++e) { const int diff = il - (16 * jt + 4 * quad + e); z[e] = diff >= 0 ? z[e] * ex2((float)diff * lg) : 0.f; }
                sc[jt] = z; }
            else sc[jt] = (f32x4){0.f, 0.f, 0.f, 0.f};
        }
#pragma unroll
        for (int pp = 0; pp < 4; ++pp) {
            if (2 * pp <= w) {
                u32x4 pw; pw.x = pk2(sc[2 * pp][0], sc[2 * pp][1]); pw.y = pk2(sc[2 * pp][2], sc[2 * pp][3]); pw.z = pk2(sc[2 * pp + 1][0], sc[2 * pp + 1][1]); pw.w = pk2(sc[2 * pp + 1][2], sc[2 * pp + 1][3]);
                const bf16x8 pf = as_bf16x8(pw);
#pragma unroll
                for (int vt = 0; vt < 8; ++vt) { const LAS unsigned char* vp = VT + (16 * vt + l15) * 272 + quad * 8;
                    const u32x2 va = *(const LAS u32x2*)(vp + (2 * pp) * 32), vb = *(const LAS u32x2*)(vp + (2 * pp + 1) * 32);
                    acc[vt] = mfma16(as_bf16x8((u32x4){va.x, va.y, vb.x, vb.y}), pf, acc[vt]); } }
        }
        float sum = 0.f;
#pragma unroll
        for (int vt = 0; vt < 8; ++vt) sum += (acc[vt][0] + acc[vt][1]) + (acc[vt][2] + acc[vt][3]);
        sum += __shfl_xor(sum, 16); sum += __shfl_xor(sum, 32);
        const float mu = sum * (1.0f / 128.0f); float var = 0.f;
#pragma unroll
        for (int vt = 0; vt < 8; ++vt) { acc[vt] = acc[vt] - mu; var += (acc[vt][0] * acc[vt][0] + acc[vt][1] * acc[vt][1]) + (acc[vt][2] * acc[vt][2] + acc[vt][3] * acc[vt][3]); }
        var += __shfl_xor(var, 16); var += __shfl_xor(var, 32);
        const float rstd = 1.0f / sqrtf(var * (1.0f / 128.0f) + 1e-6f);
#pragma unroll
        for (int vt = 0; vt < 8; ++vt) { const int dv0 = 16 * vt + 4 * quad; const u32x2 gr = __builtin_nontemporal_load((const u32x2*)(proj + row * PW + 2048 + h * 128 + dv0)); const f32x4 gw = *(const f32x4*)(P.gn_w + h * 128 + dv0);
            const float g0 = silu(bf_lo(gr.x)), g1 = silu(bf_hi(gr.x)), g2 = silu(bf_lo(gr.y)), g3 = silu(bf_hi(gr.y));
            u32x2 pk; pk.x = pk2(g0 * acc[vt][0] * rstd * gw[0], g1 * acc[vt][1] * rstd * gw[1]); pk.y = pk2(g2 * acc[vt][2] * rstd * gw[2], g3 * acc[vt][3] * rstd * gw[3]);
            *(u32x2*)(cat + row * DM + h * 128 + dv0) = pk; }
    }
    { const float* lp = lbuf + (size_t)unit * 8192 + sdv * 64 + sdk;
#pragma unroll
      for (int k = 0; k < 4; ++k) { const f32x4 l = *(const f32x4*)(lp + 4 * k);
#pragma unroll
          for (int e = 0; e < 4; ++e) S[4 * k + e] = S[4 * k + e] * g128 + l[e]; } }
}

DI void sample_ret_unit(const Params& P, LAS unsigned char* lds, int bs, int tid, int lane, int w) {
    const bf16* proj = (const bf16*)(P.ws + WS_PROJ); const float* tabc = (const float*)(P.ws + WS_TABC); const float* tabs = (const float*)(P.ws + WS_TABS); bf16* cat = (bf16*)(P.ws + WS_CAT);
    LAS float* SEGR = (LAS float*)(lds);
    LAS float* RED = (LAS float*)(lds + 49152);
    LAS float* OBUF = (LAS float*)(lds + 65536);
    LAS float* SCR = (LAS float*)(lds + 81920);
    const int r0 = MP + 4 * bs;
    const float tc0 = tabc[4096 * 32 + (lane & 31)], tc1 = tabc[4097 * 32 + (lane & 31)], tc2 = tabc[4098 * 32 + (lane & 31)], tc3 = tabc[4099 * 32 + (lane & 31)];
    const float ts0 = tabs[4096 * 32 + (lane & 31)], ts1 = tabs[4097 * 32 + (lane & 31)], ts2 = tabs[4098 * 32 + (lane & 31)], ts3 = tabs[4099 * 32 + (lane & 31)];
    for (int ch = tid; ch < 1536; ch += 512) { const int i = ch / 384, c8 = (ch % 384) * 8; const u32x4 v = *(const u32x4*)(proj + (size_t)(r0 + i) * PW + c8); float f[8]; unpack8(v, f);
        LAS float* dst = SEGR + i * 3072 + c8;
        *(LAS f32x4*)dst = (f32x4){f[0], f[1], f[2], f[3]}; *(LAS f32x4*)(dst + 4) = (f32x4){f[4], f[5], f[6], f[7]}; }
    __syncthreads();
    for (int g = w; g < 64; g += 8) {
        const int i = (g & 31) >> 3; LAS float* p = SEGR + i * 3072 + (g >> 5) * 512 + (g & 7) * 64; const float scale = g < 32 ? 1.0f : 0.125f;
        const float x = p[lane];
        const float c = i == 0 ? tc0 : i == 1 ? tc1 : i == 2 ? tc2 : tc3, s = i == 0 ? ts0 : i == 1 ? ts1 : i == 2 ? ts2 : ts3;
        const float partner = __shfl_xor(x, 32);
        const float o = lane < 32 ? x * c - partner * s : x * c + partner * s;
        p[lane] = o * scale;
    }
    __syncthreads();
    if (tid < 128) { const int h = tid >> 4, i = (tid >> 2) & 3, j = tid & 3; float d = 0.f;
        if (j <= i) { const LAS float* q = SEGR + i * 3072 + h * 64; const LAS float* k = SEGR + j * 3072 + 512 + h * 64;
            for (int dd = 0; dd < 64; ++dd) d += q[dd] * k[dd];
            d *= ex2((float)(i - j) * sel_lg2(P, h)); }
        SCR[tid] = d; }
    __syncthreads();
    {
        const int dv = tid & 127, g = tid >> 7;
        float Sn[16];
        { const float* sp0 = P.state_ret + ((size_t)(bs * 8) * 64 + 16 * g) * 128 + dv;
#pragma unroll
          for (int r = 0; r < 16; ++r) Sn[r] = __builtin_nontemporal_load(sp0 + r * 128); }
        for (int h = 0; h < 8; ++h) {
            const float lg = sel_lg2(P, h); const float g1 = ex2(lg), g2 = ex2(2.0f * lg), g3 = ex2(3.0f * lg), g4 = ex2(4.0f * lg);
            const size_t sidx = ((size_t)(bs * 8 + h) * 64 + 16 * g) * 128 + dv; float* so = P.out + OFF_RET_S + sidx;
            float S[16];
#pragma unroll
            for (int r = 0; r < 16; ++r) S[r] = Sn[r];
            if (h < 7) { const float* spn = P.state_ret + sidx + 8192;
#pragma unroll
                for (int r = 0; r < 16; ++r) Sn[r] = __builtin_nontemporal_load(spn + r * 128); }
            float part[4] = {0.f, 0.f, 0.f, 0.f};
#pragma unroll
            for (int r = 0; r < 16; ++r)
#pragma unroll
                for (int i = 0; i < 4; ++i) part[i] += SEGR[i * 3072 + h * 64 + 16 * g + r] * S[r];
#pragma unroll
            for (int i = 0; i < 4; ++i) RED[(((h & 1) * 4 + g) * 4 + i) * 128 + dv] = part[i];
            float v[4];
#pragma unroll
            for (int j = 0; j < 4; ++j) v[j] = SEGR[j * 3072 + 1024 + h * 128 + dv];
            const float v0 = v[0] * g3, v1 = v[1] * g2, v2 = v[2] * g1, v3 = v[3];
#pragma unroll
            for (int r = 0; r < 16; ++r) { const int kc = 512 + h * 64 + 16 * g + r;
                __builtin_nontemporal_store(S[r] * g4 + SEGR[kc] * v0 + SEGR[3072 + kc] * v1 + SEGR[2 * 3072 + kc] * v2 + SEGR[3 * 3072 + kc] * v3, so + r * 128); }
            __syncthreads();
            { const int i = g; float qs = 0.f;
#pragma unroll
              for (int gg = 0; gg < 4; ++gg) qs += RED[(((h & 1) * 4 + gg) * 4 + i) * 128 + dv];
              const float gi = (i == 0) ? g1 : (i == 1) ? g2 : (i == 2) ? g3 : g4;
              float o = gi * qs;
#pragma unroll
              for (int j = 0; j < 4; ++j) o += SCR[h * 16 + i * 4 + j] * v[j];
              OBUF[(h * 4 + i) * 128 + dv] = o; }
        }
    }
    __syncthreads();
    for (int rr = 4 * w; rr < 4 * w + 4; ++rr) { const int h = rr >> 2, i = rr & 3;
        const float x0 = OBUF[rr * 128 + lane], x1 = OBUF[rr * 128 + 64 + lane];
        const float mu = wave_sum(x0 + x1) * (1.0f / 128.0f); const float d0 = x0 - mu, d1 = x1 - mu;
        const float rstd = 1.0f / sqrtf(wave_sum(d0 * d0 + d1 * d1) * (1.0f / 128.0f) + 1e-6f);
        const float ga = SEGR[i * 3072 + 2048 + h * 128 + lane], gb = SEGR[i * 3072 + 2048 + h * 128 + 64 + lane];
        bf16* op = cat + (size_t)(r0 + i) * DM + h * 128;
        op[lane] = f2bf(silu(ga) * d0 * rstd * P.gn_w[h * 128 + lane]); op[64 + lane] = f2bf(silu(gb) * d1 * rstd * P.gn_w[h * 128 + 64 + lane]); }
    __syncthreads();
}
DI void sample_swa_unit(const Params& P, LAS unsigned char* lds, int bs, int tid, int lane, int w) {
    const bf16* proj = (const bf16*)(P.ws + WS_PROJ); const float* tabc = (const float*)(P.ws + WS_TABC); const float* tabs = (const float*)(P.ws + WS_TABS); bf16* cat = (bf16*)(P.ws + WS_CAT);
    LAS float* SEGS = (LAS float*)lds;
    LAS float* KF = (LAS float*)(lds + 20480);
    LAS float* VF = (LAS float*)(lds + 20480 + 34320);
    LAS float* PBUF = (LAS float*)(lds + 88592);
    const int r0 = MP + 4 * bs;
    const float tc0 = tabc[4096 * 32 + (lane & 31)], tc1 = tabc[4097 * 32 + (lane & 31)], tc2 = tabc[4098 * 32 + (lane & 31)], tc3 = tabc[4099 * 32 + (lane & 31)];
    const float ts0 = tabs[4096 * 32 + (lane & 31)], ts1 = tabs[4097 * 32 + (lane & 31)], ts2 = tabs[4098 * 32 + (lane & 31)], ts3 = tabs[4099 * 32 + (lane & 31)];
    for (int ch = tid; ch < 640; ch += 512) { const int i = ch / 160, c8 = (ch % 160) * 8; const u32x4 v = *(const u32x4*)(proj + (size_t)(r0 + i) * PW + 3072 + c8); float f[8]; unpack8(v, f);
        LAS float* dst = SEGS + i * 1280 + c8;
        *(LAS f32x4*)dst = (f32x4){f[0], f[1], f[2], f[3]}; *(LAS f32x4*)(dst + 4) = (f32x4){f[4], f[5], f[6], f[7]}; }
    {
        float* ok = P.out + OFF_SWAK_S + (size_t)bs * 16384; float* ov = P.out + OFF_SWAV_S + (size_t)bs * 16384;
        const float* ck = P.cache_k + (size_t)bs * 16384 + 512; const float* cv = P.cache_v + (size_t)bs * 16384 + 512;
        for (int e = tid * 4; e < 15872; e += 2048) { __builtin_nontemporal_store(*(const f32x4*)(ck + e), (f32x4*)(ok + e)); __builtin_nontemporal_store(*(const f32x4*)(cv + e), (f32x4*)(ov + e)); }
    }
    __syncthreads();
    for (int g = w; g < 72; g += 8) {
        LAS float* p; const float* normw; float scale; int i;
        if (g < 64) { i = g >> 4; p = SEGS + i * 1280 + (g & 15) * 64; normw = P.q_norm_w; scale = 0.125f * LOG2E; }
        else { const int gg = g - 64; i = gg >> 1; p = SEGS + i * 1280 + 1024 + (gg & 1) * 64; normw = P.k_norm_w; scale = 1.0f; }
        float x = p[lane];
        { const float ss = wave_sum(x * x); x = x * (1.0f / sqrtf(ss * (1.0f / 64.0f) + 1e-6f)) * normw[lane]; }
        const float c = i == 0 ? tc0 : i == 1 ? tc1 : i == 2 ? tc2 : tc3, s = i == 0 ? ts0 : i == 1 ? ts1 : i == 2 ? ts2 : ts3;
        const float partner = __shfl_xor(x, 32);
        const float o = lane < 32 ? x * c - partner * s : x * c + partner * s;
        p[lane] = o * scale;
    }
    __syncthreads();
    {
        float* ok = P.out + OFF_SWAK_S + (size_t)bs * 16384; float* ov = P.out + OFF_SWAV_S + (size_t)bs * 16384;
        const int i = tid >> 7, cc = tid & 127; ok[15872 + tid] = SEGS[i * 1280 + 1024 + cc]; ov[15872 + tid] = SEGS[i * 1280 + 1152 + cc];
    }
    for (int kvh = 0; kvh < 2; ++kvh) {
        for (int idx = tid; idx < 2048; idx += 512) { const int c = idx >> 4, d4 = (idx & 15) * 4; const size_t gi = ((size_t)(bs * 128 + c) * 2 + kvh) * 64 + d4;
            const f32x4 kv = __builtin_nontemporal_load((const f32x4*)(P.cache_k + gi)), vv = __builtin_nontemporal_load((const f32x4*)(P.cache_v + gi));
            KF[c * 65 + d4] = kv[0]; KF[c * 65 + d4 + 1] = kv[1]; KF[c * 65 + d4 + 2] = kv[2]; KF[c * 65 + d4 + 3] = kv[3]; *(LAS f32x4*)(VF + c * 64 + d4) = vv; }
        if (tid < 256) { const int i = tid >> 6, d = tid & 63; KF[(128 + i) * 65 + d] = SEGS[i * 1280 + 1024 + kvh * 64 + d]; VF[(128 + i) * 64 + d] = SEGS[i * 1280 + 1152 + kvh * 64 + d]; }
        __syncthreads();
        { const int qv = tid >> 4, ks = tid & 15, i = qv >> 3, hh = kvh * 8 + (qv & 7); const LAS float* q = SEGS + i * 1280 + hh * 64; const float sink2 = P.sinks[hh] * LOG2E;
          float s[9];
#pragma unroll
          for (int kk = 0; kk < 9; ++kk) s[kk] = 0.f;
          const int klast = (ks + 128 < 132) ? ks + 128 : 131;
          for (int d = 0; d < 64; ++d) { const float qd = q[d];
#pragma unroll
              for (int kk = 0; kk < 8; ++kk) s[kk] += qd * KF[(ks + 16 * kk) * 65 + d];
              s[8] += qd * KF[klast * 65 + d]; }
          float mx = -INFINITY;
#pragma unroll
          for (int kk = 0; kk < 9; ++kk) { const int key = ks + 16 * kk; const bool valid = key < 132 && (key < 128 ? key >= i : (key - 128) <= i); s[kk] = valid ? s[kk] : -INFINITY; mx = fmaxf(mx, s[kk]); }
#pragma unroll
          for (int o = 1; o < 16; o <<= 1) mx = fmaxf(mx, __shfl_xor(mx, o));
          const float m = fmaxf(mx, sink2); float sum = 0.f;
#pragma unroll
          for (int kk = 0; kk < 9; ++kk) { s[kk] = ex2(s[kk] - m); sum += s[kk]; }
#pragma unroll
          for (int o = 1; o < 16; o <<= 1) sum += __shfl_xor(sum, o);
          const float inv = 1.0f / (sum + ex2(sink2 - m));
#pragma unroll
          for (int kk = 0; kk < 9; ++kk) { const int key = ks + 16 * kk; if (key < 132) PBUF[qv * 132 + key] = s[kk] * inv; } }
        __syncthreads();
        { const int qv = tid >> 4, ds = tid & 15, i = qv >> 3, hh = kvh * 8 + (qv & 7);
          float o0 = 0.f, o1 = 0.f, o2 = 0.f, o3 = 0.f;
          for (int key = 0; key < 132; ++key) { const float pr = PBUF[qv * 132 + key]; const LAS float* vr = VF + key * 64 + ds; o0 += pr * vr[0]; o1 += pr * vr[16]; o2 += pr * vr[32]; o3 += pr * vr[48]; }
          bf16* op = cat + (size_t)(r0 + i) * DM + 1024 + hh * 64 + ds; op[0] = f2bf(o0); op[16] = f2bf(o1); op[32] = f2bf(o2); op[48] = f2bf(o3); }
        __syncthreads();
    }
}

DI void act_fixup(const Params& P, int tid, int lane, int w) {
    bf16* ACT = (bf16*)(P.ws + WS_U); const float* GHF = (const float*)(P.ws + WS_GHF); const float* UHF = (const float*)(P.ws + WS_UHF); const float* GHL = (const float*)(P.ws + WS_GHL);
    for (int idx = blockIdx.x * 512 + tid; idx < 64 * 1408; idx += gridDim.x * 512) { const int pm = idx / 1408, f0 = (idx % 1408) * 4;
        f32x4 l0 = {0.f, 0.f, 0.f, 0.f}, l1 = {0.f, 0.f, 0.f, 0.f};
        if (pm & 15) { l0 = *(const f32x4*)(GHL + ((size_t)(pm - 1) * 2) * DFF + f0); l1 = *(const f32x4*)(GHL + ((size_t)(pm - 1) * 2 + 1) * DFF + f0); }
        const f32x4 g0 = *(const f32x4*)(GHF + ((size_t)pm * 2) * DFF + f0), g1 = *(const f32x4*)(GHF + ((size_t)pm * 2 + 1) * DFF + f0);
        const f32x4 u0 = *(const f32x4*)(UHF + ((size_t)pm * 2) * DFF + f0), u1 = *(const f32x4*)(UHF + ((size_t)pm * 2 + 1) * DFF + f0);
        const f32x4 w0 = *(const f32x4*)(P.conv_w + f0), w1 = *(const f32x4*)(P.conv_w + DFF + f0), w2 = *(const f32x4*)(P.conv_w + 2 * DFF + f0), cb = *(const f32x4*)(P.conv_b + f0);
        const f32x4 c0 = cb + w0 * l0 + w1 * l1 + w2 * g0, c1 = cb + w0 * l1 + w1 * g0 + w2 * g1;
        u32x2 a0, a1; a0.x = pk2(silu(c0[0]) * u0[0], silu(c0[1]) * u0[1]); a0.y = pk2(silu(c0[2]) * u0[2], silu(c0[3]) * u0[3]); a1.x = pk2(silu(c1[0]) * u1[0], silu(c1[1]) * u1[1]); a1.y = pk2(silu(c1[2]) * u1[2], silu(c1[3]) * u1[3]);
        *(u32x2*)(ACT + ((size_t)(f0 >> 6) * MT + 256 * pm) * 64 + (f0 & 63)) = a0; *(u32x2*)(ACT + ((size_t)(f0 >> 6) * MT + 256 * pm + 1) * 64 + (f0 & 63)) = a1;
        if ((pm & 15) == 15) { float* co = P.out + OFF_CONV_P + (size_t)(pm >> 4) * 2 * DFF + f0;
            *(f32x4*)co = *(const f32x4*)(GHL + ((size_t)pm * 2) * DFF + f0); *(f32x4*)(co + DFF) = *(const f32x4*)(GHL + ((size_t)pm * 2 + 1) * DFF + f0); }
    }
    const bf16* G = (const bf16*)(P.ws + WS_GSB); const bf16* U = (const bf16*)(P.ws + WS_USB);
    for (int it = blockIdx.x * 8 + w; it < 128 * 11; it += gridDim.x * 8) {
        const int bs = it / 11, wcn = it % 11; const int f0 = (wcn * 64 + lane) * 8;
        float cw0[8], cw1[8], cw2[8], cb[8], p1[8], p2[8];
        { const f32x4* a = (const f32x4*)(P.conv_w + f0); const f32x4* b = (const f32x4*)(P.conv_w + DFF + f0); const f32x4* c = (const f32x4*)(P.conv_w + 2 * DFF + f0); const f32x4* d = (const f32x4*)(P.conv_b + f0);
#pragma unroll
          for (int k = 0; k < 2; ++k) { const f32x4 av = a[k], bv = b[k], cv = c[k], dv = d[k];
#pragma unroll
              for (int e = 0; e < 4; ++e) { cw0[4 * k + e] = av[e]; cw1[4 * k + e] = bv[e]; cw2[4 * k + e] = cv[e]; cb[4 * k + e] = dv[e]; } } }
        { const float* st = P.state_conv + (size_t)bs * 2 * DFF + f0; const f32x4 a0 = *(const f32x4*)st, a1 = *(const f32x4*)(st + 4), b0 = *(const f32x4*)(st + DFF), b1 = *(const f32x4*)(st + DFF + 4);
#pragma unroll
          for (int e = 0; e < 4; ++e) { p2[e] = a0[e]; p2[4 + e] = a1[e]; p1[e] = b0[e]; p1[4 + e] = b1[e]; } }
        u32x4 gq[4], uq[4];
#pragma unroll
        for (int i = 0; i < 4; ++i) { gq[i] = __builtin_nontemporal_load((const u32x4*)(G + (size_t)(4 * bs + i) * DFF + f0)); uq[i] = __builtin_nontemporal_load((const u32x4*)(U + (size_t)(4 * bs + i) * DFF + f0)); }
#pragma unroll
        for (int i = 0; i < 4; ++i) {
            float g[8], u[8], a[8]; unpack8(gq[i], g); unpack8(uq[i], u);
#pragma unroll
            for (int e = 0; e < 8; ++e) { const float gc = cb[e] + cw0[e] * p2[e] + cw1[e] * p1[e] + cw2[e] * g[e]; a[e] = silu(gc) * u[e]; p2[e] = p1[e]; p1[e] = g[e]; }
            *(u32x4*)(ACT + ((size_t)(f0 >> 6) * MT + MP + 4 * bs + i) * 64 + (f0 & 63)) = pack8(a);
            if (i >= 2) { float* co = P.out + OFF_CONV_S + ((size_t)bs * 2 + (i - 2)) * DFF + f0; *(f32x4*)co = (f32x4){g[0], g[1], g[2], g[3]}; *(f32x4*)(co + 4) = (f32x4){g[4], g[5], g[6], g[7]}; }
        }
    }
}

#define XB_TMO      128
#define XB_XCNT(j)  (256  + 64 * (j))
#define XB_XSUB(j)  (1280 + 64 * (j))
#define XB_XGEN(j)  (2304 + 64 * (j))
#define XB_TOP      3328
#define XB_TOPGEN   3392
#define XCD_BAR_WORDS 3456
#define XB_SPIN_CAP (1u << 18)

__device__ __forceinline__ unsigned xb_ld(unsigned* p)              { return __hip_atomic_load(p, __ATOMIC_RELAXED, __HIP_MEMORY_SCOPE_AGENT); }
__device__ __forceinline__ unsigned xb_add(unsigned* p, unsigned v) { return __hip_atomic_fetch_add(p, v, __ATOMIC_RELAXED, __HIP_MEMORY_SCOPE_AGENT); }
__device__ __forceinline__ unsigned xb_xcc_id() { return (unsigned)__builtin_amdgcn_s_getreg((3 << 11) | 20) & 0xFu; }
#define XB_SPIN(cond, bar) do { unsigned _sp = 0; while (cond) { __builtin_amdgcn_s_sleep(1); \
    if ((++_sp & 255u) == 0u) { if (xb_ld(&(bar)[XB_TMO])) break; if (_sp > XB_SPIN_CAP) { atomicAdd(&(bar)[XB_TMO], 1u); break; } } } } while (0)

struct XcdBarrier {
    unsigned* bar; unsigned x;
    volatile LAS unsigned* st;
};

__device__ __forceinline__ XcdBarrier xcd_barrier_post(unsigned* bar, volatile LAS unsigned* st) {
    XcdBarrier b; b.bar = bar; b.x = xb_xcc_id(); b.st = st;
    if (threadIdx.x == 0) (void)xb_add(&bar[XB_XCNT(b.x)], 1u);
    return b;
}
__device__ __forceinline__ void xcd_barrier_complete(unsigned* bar, unsigned x, unsigned& nloc, unsigned& nx) {
    const unsigned G = gridDim.x * gridDim.y * gridDim.z;
    unsigned sum, cnt, mine, sp = 0u;
    for (;;) {
        sum = 0u; cnt = 0u; mine = 0u;
#pragma unroll
        for (unsigned j = 0; j < 16; ++j) { const unsigned c = xb_ld(&bar[XB_XCNT(j)]); sum += c; cnt += (c > 0u) ? 1u : 0u; mine = (j == x) ? c : mine; }
        if (sum == G) break;
        __builtin_amdgcn_s_sleep(1);
        if ((++sp & 255u) == 0u) { if (xb_ld(&bar[XB_TMO])) break; if (sp > XB_SPIN_CAP) { atomicAdd(&bar[XB_TMO], 1u); break; } }
    }
    nloc = mine > 0u ? mine : 1u; nx = cnt > 0u ? cnt : 1u;
}

__device__ __forceinline__ void xcd_barrier(const XcdBarrier& b) {
    asm volatile("s_waitcnt vmcnt(0)" ::: "memory");
    __syncthreads();
    if (threadIdx.x == 0) {
        unsigned* bar = b.bar;
        __builtin_amdgcn_s_waitcnt(0);
        unsigned nloc = b.st[0], nx = b.st[1];
        if (nloc == 0u) { xcd_barrier_complete(bar, b.x, nloc, nx); b.st[0] = nloc; b.st[1] = nx; }
        const unsigned old = xb_add(&bar[XB_XSUB(b.x)], 1u);
        const unsigned gen = old / nloc;
        if (old + 1u == (gen + 1u) * nloc) {
            __builtin_amdgcn_fence(__ATOMIC_RELEASE, "agent");
            asm volatile("s_waitcnt vmcnt(0)" ::: "memory");
            const unsigned og = xb_add(&bar[XB_TOP], 1u);
            const unsigned tg = og / nx;
            if (og + 1u == (tg + 1u) * nx) xb_add(&bar[XB_TOPGEN], 1u);
            else XB_SPIN(xb_ld(&bar[XB_TOPGEN]) == tg, bar);
            __builtin_amdgcn_fence(__ATOMIC_ACQUIRE, "agent");
            xb_add(&bar[XB_XGEN(b.x)], 1u);
            asm volatile("s_waitcnt vmcnt(0)" ::: "memory");
        } else {
            XB_SPIN(xb_ld(&bar[XB_XGEN(b.x)]) == gen, bar);
            __builtin_amdgcn_fence(__ATOMIC_ACQUIRE, "agent");
            asm volatile("s_waitcnt vmcnt(0)" ::: "memory");
        }
    }
    __syncthreads();
}

__global__ void __launch_bounds__(512, 2) fwd_kernel(Params P) {
    extern __shared__ __attribute__((aligned(16))) unsigned char lds_raw[];
    LAS unsigned char* lds = (LAS unsigned char*)lds_raw;
    const int tid = threadIdx.x, lane = tid & 63, w = __builtin_amdgcn_readfirstlane(tid >> 6);
    const int lo = P.ph_lo, hi = P.ph_hi;
#define IN(k) (lo <= (k) && (k) < hi)
#define SEAM(k) do { if (IN(k) && IN((k) + 1)) { xcd_barrier(bar); } } while (0)
    volatile LAS unsigned* bst = (volatile LAS unsigned*)(lds + LDS_BYTES - 16);
    if (tid < 2) bst[tid] = 0u;
    __syncthreads();
    XcdBarrier bar; bar.bar = (unsigned*)P.ws; bar.x = 0; bar.st = bst;
    if (hi - lo > 1) bar = xcd_barrier_post((unsigned*)P.ws, bst);
    if (hi > 1000) cg::this_grid().sync();
    if (IN(0)) { p0_prologue(P, lds, tid, lane, w); }
    SEAM(0);
    if (IN(1)) { pg8::Gemm g{(const bf16*)(P.ws + WS_HB), (const bf16*)(P.ws + WS_WIN), MT, PW, DM}; pg8::StaticOrder S; S.init(MT, PW, gridDim.x, (int)blockIdx.x, DM);
        pg8::EpiProj E{(bf16*)(P.ws + WS_PROJ), PW}; pg8::gemm_phase<pg8::EpiProj, pg8::StaticOrder, true, true>(lds, g, S, E);
        tail_transposes(P, lds, (MT / 256) * (PW / 256), 0, lane, w); }
    SEAM(1);
    if (IN(2)) {
        if (P.dummy == 0 || P.dummy == 1) for (int u = blockIdx.x; u < 256; u += gridDim.x) swa_prompt_unit(P, lds, u, tid, lane, w);
        if (P.dummy == 0 || P.dummy == 2) for (int u = blockIdx.x; u < 256; u += gridDim.x) { if (u < 128) sample_ret_unit(P, lds, u, tid, lane, w); else sample_swa_unit(P, lds, u - 128, tid, lane, w); }
        if (P.dummy == 1 || P.dummy == 2) {} else if (gridDim.x == 256) {
            const int c = blockIdx.x;
            if (c < 128) { for (int k = 0; k < 3; ++k) ret_l_unit(P, lds, c + 128 * k, tid, lane, w, k & 1); }
            else { for (int k = 0; k < 5; ++k) ret_l_unit(P, lds, 384 + (c - 128) + 128 * k, tid, lane, w, k & 1); }
        } else { int k = 0; for (int u = blockIdx.x; u < 1024; u += gridDim.x, ++k) ret_l_unit(P, lds, u, tid, lane, w, k & 1); }
        __syncthreads();
    }
    SEAM(2);
    if (IN(3)) { }
    if (IN(4)) {
        const float* lbuf = (const float*)(P.ws + WS_LBUF); const int sdv = tid >> 2, sdk = (tid & 3) * 16;
        for (int grp = blockIdx.x; grp < 256; grp += gridDim.x) {
            const int bh = grp >> 3, q = grp & 7; const float g128 = ex2(128.0f * sel_lg2(P, bh & 7));
            float S[16];
#pragma unroll
            for (int e = 0; e < 16; ++e) S[e] = 0.f;
            const float* lp = lbuf + (size_t)(bh * 32) * 8192 + sdv * 64 + sdk;
#pragma unroll 4
            for (int c = 0; c < 4 * q; ++c) { const f32x4 l0 = *(const f32x4*)(lp + (size_t)c * 8192), l1 = *(const f32x4*)(lp + (size_t)c * 8192 + 4), l2 = *(const f32x4*)(lp + (size_t)c * 8192 + 8), l3 = *(const f32x4*)(lp + (size_t)c * 8192 + 12);
#pragma unroll
                for (int e = 0; e < 4; ++e) { S[e] = S[e] * g128 + l0[e]; S[4 + e] = S[4 + e] * g128 + l1[e]; S[8 + e] = S[8 + e] * g128 + l2[e]; S[12 + e] = S[12 + e] * g128 + l3[e]; } }
#pragma unroll 1
            for (int k = 0; k < 4; ++k) ret_c_unit(P, lds, bh * 32 + 4 * q + k, tid, lane, w, k & 1, S, g128);
            if (q == 7) { int sdv2 = sdv, sdk2 = sdk; asm volatile("" : "+v"(sdv2), "+v"(sdk2));
                float* op = P.out + OFF_RET_P + ((size_t)bh * 64 + sdk2) * 128 + sdv2;
#pragma unroll
                for (int e = 0; e < 16; ++e) op[(size_t)e * 128] = S[e]; }
            __syncthreads();
        }
    }
    SEAM(4);
    if (IN(5)) { pg8::Gemm g{(const bf16*)(P.ws + WS_CAT), (const bf16*)(P.ws + WS_WO), MT, DM, DM}; pg8::TailSplitOrder<4> S; S.init(DM, gridDim.x, (int)blockIdx.x, DM, 8);
        pg8::EpiOut E{P.x_prompt, P.x_sample, P.out, (bf16*)(P.ws + WS_HB), (float*)(P.ws + WS_SSQ), (float*)(P.ws + WS_PART), DM / 64}; pg8::gemm_phase<pg8::EpiOut, pg8::TailSplitOrder<4>, true, true>(lds, g, S, E);
        tail_transposes(P, lds, 512 + 64, 1, lane, w); }
    SEAM(5);
    if (IN(6)) {
        const float* part = (const float*)(P.ws + WS_PART); bf16* hb = (bf16*)(P.ws + WS_HB); float* ssq = (float*)(P.ws + WS_SSQ);
        for (int rr = blockIdx.x * 8 + w; rr < 512; rr += gridDim.x * 8) {
            const float* xr = P.x_sample + (size_t)rr * DM; float* orow = P.out + (size_t)(MP + rr) * DM; float ss = 0.f;
#pragma unroll
            for (int j = 0; j < 8; ++j) { const int idx = 4 * lane + 256 * j; f32x4 v = *(const f32x4*)(xr + idx);
#pragma unroll
                for (int ks = 0; ks < 4; ++ks) v = v + __builtin_nontemporal_load((const f32x4*)(part + (size_t)ks * (512 * 2048) + (size_t)rr * DM + idx));
                *(f32x4*)(orow + idx) = v; u32x2 pk; pk.x = pk2(v[0], v[1]); pk.y = pk2(v[2], v[3]); *(u32x2*)(hb + (size_t)(MP + rr) * DM + idx) = pk;
                ss += (v[0] * v[0] + v[1] * v[1]) + (v[2] * v[2] + v[3] * v[3]); }
            ss = wave_sum(ss); if (lane == 0) ssq[MP + rr] = ss;
        }
    }
    SEAM(6);
    if (IN(7)) { pg8::Gemm g{(const bf16*)(P.ws + WS_HB), (const bf16*)(P.ws + WS_WUP), MT, 2 * DFF, DM}; pg8::StaticOrder S; S.init(MT, 2 * DFF, gridDim.x, (int)blockIdx.x, DM);
        pg8::EpiUpAct E{(bf16*)(P.ws + WS_U), (bf16*)(P.ws + WS_GSB), (bf16*)(P.ws + WS_USB), (float*)(P.ws + WS_GHF), (float*)(P.ws + WS_UHF), (float*)(P.ws + WS_GHL), (const float*)(P.ws + WS_SSQ), P.conv_w, P.conv_b, (LAS float*)(lds + 131072)};
        pg8::gemm_phase<pg8::EpiUpAct, pg8::StaticOrder, true, true>(lds, g, S, E);
        tail_transposes(P, lds, (MT / 256) * (2 * DFF / 256), 2, lane, w); }
    SEAM(7);
    if (IN(8)) { act_fixup(P, tid, lane, w); }
    SEAM(8);
    if (IN(9)) { pg8::Gemm g{(const bf16*)(P.ws + WS_U), (const bf16*)(P.ws + WS_WDN), MT, DM, DFF, 1}; pg8::TailSplitOrder<KSPLIT> S; S.init(DM, gridDim.x, (int)blockIdx.x, DFF, 4);
        pg8::EpiDown E{P.dummy ? (float*)(P.ws + WS_G) : P.out, DFF / 64, (const bf16*)(P.ws + WS_HB), (float*)(P.ws + WS_PART)}; pg8::gemm_phase<pg8::EpiDown, pg8::TailSplitOrder<KSPLIT>, true, true>(lds, g, S, E); }
    SEAM(9);
    if (IN(10)) {
        const float* part = (const float*)(P.ws + WS_PART); float* o = P.out + (size_t)MP * DM;
        for (int idx = blockIdx.x * 512 + tid; idx < 512 * 2048 / 4; idx += gridDim.x * 512) { f32x4 v = *(const f32x4*)(o + 4 * (size_t)idx);
#pragma unroll
            for (int ks = 0; ks < KSPLIT; ++ks) v = v + __builtin_nontemporal_load((const f32x4*)(part + (size_t)ks * (512 * 2048) + 4 * (size_t)idx));
            *(f32x4*)(o + 4 * (size_t)idx) = v; }
    }
#undef IN
#undef SEAM
}

extern "C" void kernel_launch(void* const* d_in, const int* in_sizes, int n_in, void* d_out, int out_size, void* d_ws, size_t ws_size, hipStream_t stream) {
    static int grid = 0;
    if (grid == 0) {
        if (n_in != 18 || in_sizes[0] != MP * DM || (size_t)out_size != OUT_TOTAL || ws_size < WS_END) {
            fprintf(stderr, "kernel_launch: unexpected shapes: n_in %d in0 %d out %d ws %zu (need %zu)\n", n_in, n_in > 0 ? in_sizes[0] : -1, out_size, ws_size, (size_t)WS_END); grid = -1; return; }
        int dev = 0, cus = 0, per_cu = 0;
        if (hipGetDevice(&dev) != hipSuccess || hipDeviceGetAttribute(&cus, hipDeviceAttributeMultiprocessorCount, dev) != hipSuccess) { grid = -1; return; }
        if (hipFuncSetAttribute((const void*)fwd_kernel, hipFuncAttributeMaxDynamicSharedMemorySize, LDS_BYTES) != hipSuccess) { fprintf(stderr, "kernel_launch: hipFuncSetAttribute failed\n"); grid = -1; return; }
        if (hipOccupancyMaxActiveBlocksPerMultiprocessor(&per_cu, (const void*)fwd_kernel, 512, LDS_BYTES) != hipSuccess || per_cu < 1) { fprintf(stderr, "kernel_launch: occupancy query says %d\n", per_cu); per_cu = 1; }
        (void)hipGetLastError();
        grid = cus * 1;
    }
    if (grid < 0) return;
    Params p{};
    p.x_prompt = (const float*)d_in[0]; p.x_sample = (const float*)d_in[1]; p.state_ret = (const float*)d_in[2]; p.cache_k = (const float*)d_in[3]; p.cache_v = (const float*)d_in[4];
    p.state_conv = (const float*)d_in[5]; p.attn_norm_w = (const float*)d_in[6]; p.w_in = (const float*)d_in[7]; p.q_norm_w = (const float*)d_in[8]; p.k_norm_w = (const float*)d_in[9];
    p.sinks = (const float*)d_in[10]; p.gn_w = (const float*)d_in[11]; p.w_o = (const float*)d_in[12]; p.ffn_norm_w = (const float*)d_in[13]; p.w_up = (const float*)d_in[14];
    p.conv_w = (const float*)d_in[15]; p.conv_b = (const float*)d_in[16]; p.w_down = (const float*)d_in[17];
    p.out = (float*)d_out; p.ws = (unsigned char*)d_ws;
    for (int i = 0; i < 32; ++i) p.inv_freq[i] = (float)pow(10000.0, -(double)i / 32.0);
    for (int h = 0; h < 8; ++h) p.lg2[h] = (float)log2(1.0 - exp2(-5.0 - (double)h));
#if MK_N_LAUNCHES == 1
    p.ph_lo = 0; p.ph_hi = NPH;
    if (hipMemsetAsync(d_ws, 0, 16384, stream) != hipSuccess) { fprintf(stderr, "kernel_launch: memset failed\n"); return; }
    void* args[] = {&p};
    hipError_t e = hipLaunchCooperativeKernel((const void*)fwd_kernel, dim3(grid), dim3(512), args, LDS_BYTES, stream);
    if (e != hipSuccess) fprintf(stderr, "kernel_launch: cooperative launch failed: %s (grid %d)\n", hipGetErrorString(e), grid);
#else
    {
        const int seq[] = PROBE_SEQ;
        for (unsigned k = 0; k < sizeof(seq) / sizeof(seq[0]); ++k) { p.ph_lo = seq[k] % 100; p.ph_hi = p.ph_lo + 1; p.dummy = seq[k] / 100; hipLaunchKernelGGL(fwd_kernel, dim3(grid), dim3(512), LDS_BYTES, stream, p); }
    }
#endif
}
```

```cpp
#include <hip/hip_runtime.h>
#include <hip/hip_cooperative_groups.h>
#include <cstdio>
#include <cstdint>
#include <cmath>
namespace cg = cooperative_groups;
namespace pg8 {
#define PG8_LAS __attribute__((address_space(3)))
typedef unsigned short bf16_t;
typedef short bf16x8 __attribute__((ext_vector_type(8)));
typedef float f32x4 __attribute__((ext_vector_type(4)));
typedef unsigned u32x4 __attribute__((ext_vector_type(4)));
constexpr int BM = 256, BK = 64, HALF = 128, HTB = HALF * BK * 2  , STAGE_BYTES = 8 * HTB, NXCD = 8, WGM = 8;

__host__ __device__ __forceinline__ int lds_byte(int r, int c) { const int st = (r >> 4) * 2 + (c >> 5), rr = r & 15, cc = c & 31, ob = rr * 64 + cc * 2; return st * 1024 + (ob ^ (((ob >> 9) & 1) << 5)); }
__host__ __device__ __forceinline__ void stage_rc(int b, int& R, int& C) { const int st = b / 1024, sb = b % 1024, swz = sb ^ (((sb >> 9) & 1) << 5); R = (st >> 1) * 16 + swz / 64; C = (st & 1) * 32 + (swz % 64) / 2; }
__host__ __device__ __forceinline__ int perm32(int rho) { const int n = rho >> 4, i = rho & 15; return 8 * (i >> 2) + 4 * n + (i & 3); }

struct Unit { int pm, pn, kt0, nt; };
struct Gemm { const bf16_t* A; const bf16_t* Bt; int M, N, K; int a_ktm; };

struct StaticOrder {
    int nM, nN, nwg, G, c, ntk, wgm;
    __host__ __device__ void init(int M, int N, int G_, int c_, int K_, int wgm_ = WGM) { nM = M / BM; nN = N / BM; nwg = nM * nN; G = G_; c = c_; ntk = K_ / BK; wgm = wgm_; }
    __host__ __device__ __forceinline__ bool next(int i, Unit& u) const {
        const long L = (long)i * G + c; if (L >= nwg) return false;
        int wgid = (int)L; { const int q = nwg / NXCD, r = nwg % NXCD, xcd = wgid % NXCD, off = wgid / NXCD; wgid = (xcd < r ? xcd * (q + 1) : r * (q + 1) + (xcd - r) * q) + off; }
        const int nig = wgm * nN, gid = wgid / nig, fm = gid * wgm, gsz = (nM - fm) < wgm ? (nM - fm) : wgm;
        u.pm = fm + ((wgid % nig) % gsz); u.pn = (wgid % nig) / gsz; u.kt0 = 0; u.nt = ntk; return true;
    }
    __device__ __forceinline__ void a_ready(const Unit&) const {}
    __device__ __forceinline__ void done(const Unit&) const {}
};

template <int KS> struct TailSplitOrder {
    StaticOrder so; int ntk;
    __host__ __device__ void init(int N, int G_, int c_, int K_, int wgm_) { so.init(16384, N, G_, c_, K_, wgm_); ntk = K_ / BK; }
    __host__ __device__ __forceinline__ bool next(int i, Unit& u) const {
        const long L = (long)i * so.G + so.c; Unit a; a.pm = 0; a.pn = 0; a.kt0 = 0; a.nt = ntk;
        const bool okA = so.next(i, a);
        const int s = (int)(L - so.nwg); const bool okB = (s >= 0) && (s < 2 * so.nN * KS);
        const int ks = s % KS, t = s / KS; const int ntb = ntk / KS;
        u.pm = okA ? a.pm : 64 + t / so.nN; u.pn = okA ? a.pn : t % so.nN; u.nt = okA ? a.nt : ntb; u.kt0 = okA ? 0 : ks * ntb;
        return okA || okB;
    }
    __device__ __forceinline__ void a_ready(const Unit&) const {}
    __device__ __forceinline__ void done(const Unit&) const {}
};

__device__ __forceinline__ unsigned cvt_pk_bf16(float lo, float hi) { unsigned r; asm volatile("v_cvt_pk_bf16_f32 %0, %1, %2" : "=v"(r) : "v"(lo), "v"(hi)); return r; }
constexpr int MROWS_PROMPT = 16384;
struct EpiProj {
    static constexpr bool PERM = true, AFTER_DRAIN = false;
    bf16_t* O; int ldc;
    __device__ __forceinline__ void operator()(const f32x4 (&acc)[2][2][4][2], const Unit& u, int wr, int wc, int fr, int fq) const {
        const int row0 = u.pm * BM + wr * 64 + fr; const int col0 = u.pn * BM + wc * 32 + 8 * fq;
#pragma unroll
        for (int ai = 0; ai < 2; ++ai)
#pragma unroll
            for (int m = 0; m < 4; ++m) { bf16_t* rowp = O + (size_t)(row0 + ai * HALF + m * 16) * ldc + col0;
#pragma unroll
                for (int bj = 0; bj < 2; ++bj) { const f32x4 v0 = acc[ai][bj][m][0], v1 = acc[ai][bj][m][1];
                    u32x4 w; w.x = cvt_pk_bf16(v0[0], v0[1]); w.y = cvt_pk_bf16(v0[2], v0[3]); w.z = cvt_pk_bf16(v1[0], v1[1]); w.w = cvt_pk_bf16(v1[2], v1[3]);
                    *(u32x4*)(rowp + bj * HALF) = w; } }
    }
};
struct EpiOut {
    static constexpr bool PERM = true, AFTER_DRAIN = false;
    const float* xp; const float* xs; float* out; bf16_t* hb; float* ssq; float* part; int ntk;
    __device__ __forceinline__ void operator()(const f32x4 (&acc)[2][2][4][2], const Unit& u, int wr, int wc, int fr, int fq) const {
        const int row0 = u.pm * BM + wr * 64 + fr; const int col0 = u.pn * BM + wc * 32 + 8 * fq;
        if (u.nt != ntk) {
            float* pp = part + (size_t)(u.kt0 / u.nt) * (512 * 2048);
#pragma unroll
            for (int ai = 0; ai < 2; ++ai)
#pragma unroll
                for (int m = 0; m < 4; ++m) { const size_t off = (size_t)(row0 + ai * HALF + m * 16 - MROWS_PROMPT) * 2048 + col0;
#pragma unroll
                    for (int bj = 0; bj < 2; ++bj) { *(f32x4*)(pp + off + bj * HALF) = acc[ai][bj][m][0]; *(f32x4*)(pp + off + bj * HALF + 4) = acc[ai][bj][m][1]; } }
            return;
        }
        const float* xb = xp;
#pragma unroll
        for (int ai = 0; ai < 2; ++ai) {
            f32x4 pre[4][2][2];
#pragma unroll
            for (int m = 0; m < 4; ++m) { const size_t off = (size_t)(row0 + ai * HALF + m * 16) * 2048 + col0;
#pragma unroll
                for (int bj = 0; bj < 2; ++bj) { pre[m][bj][0] = __builtin_nontemporal_load((const f32x4*)(xb + off + bj * HALF)); pre[m][bj][1] = __builtin_nontemporal_load((const f32x4*)(xb + off + bj * HALF + 4)); } }
#pragma unroll
            for (int m = 0; m < 4; ++m) { const int row = row0 + ai * HALF + m * 16; const size_t off = (size_t)row * 2048 + col0; float ss = 0.f;
#pragma unroll
                for (int bj = 0; bj < 2; ++bj) { const f32x4 h0 = pre[m][bj][0] + acc[ai][bj][m][0], h1 = pre[m][bj][1] + acc[ai][bj][m][1];
                    u32x4 w; w.x = cvt_pk_bf16(h0[0], h0[1]); w.y = cvt_pk_bf16(h0[2], h0[3]); w.z = cvt_pk_bf16(h1[0], h1[1]); w.w = cvt_pk_bf16(h1[2], h1[3]);
                    *(u32x4*)(hb + off + bj * HALF) = w;
                    ss += (h0[0] * h0[0] + h0[1] * h0[1]) + (h0[2] * h0[2] + h0[3] * h0[3]) + (h1[0] * h1[0] + h1[1] * h1[1]) + (h1[2] * h1[2] + h1[3] * h1[3]); }
                ss += __shfl_xor(ss, 16); ss += __shfl_xor(ss, 32);
                if (fq == 0) unsafeAtomicAdd(ssq + row, ss); }
        }
    }
};
struct EpiUpAct {
    static constexpr bool PERM = true, AFTER_DRAIN = false;
    bf16_t* ACT; bf16_t* GSB; bf16_t* USB; float* GHF; float* UHF; float* GHL; const float* ssq; const float* conv_w; const float* conv_b; PG8_LAS float* halo;
    __device__ __forceinline__ void operator()(f32x4 (&acc)[2][2][4][2], const Unit& u, int wr, int wc, int fr, int fq) const {
        const int row0 = u.pm * BM + wr * 64 + fr; const int f0 = u.pn * 128 + wc * 32 + 8 * fq;
        float cw0[8], cw1[8], cw2[8], cb[8];
#pragma unroll
        for (int k = 0; k < 2; ++k) { const f32x4 a = *(const f32x4*)(conv_w + f0 + 4 * k), b = *(const f32x4*)(conv_w + 5632 + f0 + 4 * k), c = *(const f32x4*)(conv_w + 2 * 5632 + f0 + 4 * k), d = *(const f32x4*)(conv_b + f0 + 4 * k);
#pragma unroll
            for (int e = 0; e < 4; ++e) { cw0[4 * k + e] = a[e]; cw1[4 * k + e] = b[e]; cw2[4 * k + e] = c[e]; cb[4 * k + e] = d[e]; } }
        float rsv[2][4];
#pragma unroll
        for (int ai = 0; ai < 2; ++ai)
#pragma unroll
            for (int m = 0; m < 4; ++m) rsv[ai][m] = ssq[row0 + ai * HALF + m * 16];
#pragma unroll
        for (int ai = 0; ai < 2; ++ai)
#pragma unroll
            for (int m = 0; m < 4; ++m) { const float rs = 1.0f / sqrtf(rsv[ai][m] * (1.0f / 2048.0f) + 1e-6f);
#pragma unroll
                for (int bj = 0; bj < 2; ++bj) { acc[ai][bj][m][0] = acc[ai][bj][m][0] * rs; acc[ai][bj][m][1] = acc[ai][bj][m][1] * rs; } }
        if (u.pm >= 64) {
#pragma unroll
            for (int ai = 0; ai < 2; ++ai)
#pragma unroll
                for (int m = 0; m < 4; ++m) { const size_t off = (size_t)(row0 + ai * HALF + m * 16 - MROWS_PROMPT) * 5632 + f0;
                    u32x4 w; w.x = cvt_pk_bf16(acc[ai][0][m][0][0], acc[ai][0][m][0][1]); w.y = cvt_pk_bf16(acc[ai][0][m][0][2], acc[ai][0][m][0][3]); w.z = cvt_pk_bf16(acc[ai][0][m][1][0], acc[ai][0][m][1][1]); w.w = cvt_pk_bf16(acc[ai][0][m][1][2], acc[ai][0][m][1][3]);
                    *(u32x4*)(GSB + off) = w;
                    w.x = cvt_pk_bf16(acc[ai][1][m][0][0], acc[ai][1][m][0][1]); w.y = cvt_pk_bf16(acc[ai][1][m][0][2], acc[ai][1][m][0][3]); w.z = cvt_pk_bf16(acc[ai][1][m][1][0], acc[ai][1][m][1][1]); w.w = cvt_pk_bf16(acc[ai][1][m][1][2], acc[ai][1][m][1][3]);
                    *(u32x4*)(USB + off) = w; }
            return;
        }
        if (fr >= 14) {
#pragma unroll
            for (int ai = 0; ai < 2; ++ai) { PG8_LAS float* hp = halo + ((ai * 2 + wr) * 2 + (fr - 14)) * 128 + wc * 32 + 8 * fq; *(PG8_LAS f32x4*)hp = acc[ai][0][3][0]; *(PG8_LAS f32x4*)(hp + 4) = acc[ai][0][3][1]; }
            if (wr == 1) { float* gp = GHL + ((size_t)u.pm * 2 + (fr - 14)) * 5632 + f0; *(f32x4*)gp = acc[1][0][3][0]; *(f32x4*)(gp + 4) = acc[1][0][3][1]; }
        }
        if (wr == 0 && fr < 2) { float* gp = GHF + ((size_t)u.pm * 2 + fr) * 5632 + f0; *(f32x4*)gp = acc[0][0][0][0]; *(f32x4*)(gp + 4) = acc[0][0][0][1];
            float* up = UHF + ((size_t)u.pm * 2 + fr) * 5632 + f0; *(f32x4*)up = acc[0][1][0][0]; *(f32x4*)(up + 4) = acc[0][1][0][1]; }
        asm volatile("s_waitcnt lgkmcnt(0)" ::: "memory"); __builtin_amdgcn_s_barrier(); asm volatile("" ::: "memory");
#pragma unroll
        for (int ai = 0; ai < 2; ++ai) {
            const int pb = ai * 2 + wr - 1;
            float prev[8];
            if (pb >= 0) { const PG8_LAS float* hp = halo + (pb * 2 + (fr & 1)) * 128 + wc * 32 + 8 * fq; const f32x4 a = *(const PG8_LAS f32x4*)hp, b = *(const PG8_LAS f32x4*)(hp + 4);
#pragma unroll
                for (int e = 0; e < 4; ++e) { prev[e] = a[e]; prev[4 + e] = b[e]; } }
            else {
#pragma unroll
                for (int k = 0; k < 8; ++k) prev[k] = 0.f; }
#pragma unroll
            for (int m = 0; m < 4; ++m) {
                float a[8];
#pragma unroll
                for (int kk = 0; kk < 4; ++kk) {
                    typedef float f32x2p __attribute__((ext_vector_type(2)));
                    const int k = 2 * kk;
                    const f32x2p g2 = {acc[ai][0][m][k >> 2][k & 3], acc[ai][0][m][k >> 2][(k & 3) + 1]}, u2 = {acc[ai][1][m][k >> 2][k & 3], acc[ai][1][m][k >> 2][(k & 3) + 1]};
                    f32x2p p1v, p2v;
#pragma unroll
                    for (int j = 0; j < 2; ++j) { const float g = g2[j];
                        const float t1 = fr == 15 ? prev[k + j] : g, t2 = fr >= 14 ? prev[k + j] : g;
                        int o1, o2; asm volatile("" : "=v"(o1), "=v"(o2));
                        p1v[j] = __int_as_float(__builtin_amdgcn_update_dpp(o1, __float_as_int(t1), 0x121, 0xf, 0xf, false));
                        p2v[j] = __int_as_float(__builtin_amdgcn_update_dpp(o2, __float_as_int(t2), 0x122, 0xf, 0xf, false));
                        prev[k + j] = g; }
                    const f32x2p c0 = {cw0[k], cw0[k + 1]}, c1 = {cw1[k], cw1[k + 1]}, c2 = {cw2[k], cw2[k + 1]}, cbv = {cb[k], cb[k + 1]};
                    const f32x2p gc = __builtin_elementwise_fma(c2, g2, __builtin_elementwise_fma(c1, p1v, __builtin_elementwise_fma(c0, p2v, cbv)));
                    const f32x2p ex = gc * -1.4426950408889634f; f32x2p den; den[0] = __builtin_amdgcn_exp2f(ex[0]); den[1] = __builtin_amdgcn_exp2f(ex[1]); den = den + 1.0f;
                    f32x2p rc; rc[0] = __builtin_amdgcn_rcpf(den[0]); rc[1] = __builtin_amdgcn_rcpf(den[1]);
                    const f32x2p av = (gc * u2) * rc; a[k] = av[0]; a[k + 1] = av[1]; }
                if (!(ai == 0 && wr == 0 && m == 0 && fr < 2)) { u32x4 w; w.x = cvt_pk_bf16(a[0], a[1]); w.y = cvt_pk_bf16(a[2], a[3]); w.z = cvt_pk_bf16(a[4], a[5]); w.w = cvt_pk_bf16(a[6], a[7]);
                    *(u32x4*)(ACT + ((size_t)(f0 >> 6) * 16896 + (row0 + ai * HALF + m * 16)) * 64 + (f0 & 63)) = w; }
            }
        }
    }
};
struct EpiDown {
    static constexpr bool PERM = true, AFTER_DRAIN = false;
    float* out; int ntk; const bf16_t* hb; float* part;
    __device__ __forceinline__ void operator()(const f32x4 (&acc)[2][2][4][2], const Unit& u, int wr, int wc, int fr, int fq) const {
        const int row0 = u.pm * BM + wr * 64 + fr; const int col0 = u.pn * BM + wc * 32 + 8 * fq;
        if (u.nt == ntk) {
#pragma unroll
        for (int ai = 0; ai < 2; ++ai) {
            u32x4 pre[4][2];
#pragma unroll
            for (int m = 0; m < 4; ++m) { const size_t off = (size_t)(row0 + ai * HALF + m * 16) * 2048 + col0;
#pragma unroll
                for (int bj = 0; bj < 2; ++bj) pre[m][bj] = __builtin_nontemporal_load((const u32x4*)(hb + off + bj * HALF)); }
#pragma unroll
            for (int m = 0; m < 4; ++m) { const size_t off = (size_t)(row0 + ai * HALF + m * 16) * 2048 + col0;
#pragma unroll
                for (int bj = 0; bj < 2; ++bj) { const u32x4 p = pre[m][bj];
                    const f32x4 h0 = {__uint_as_float(p.x << 16), __uint_as_float(p.x & 0xffff0000u), __uint_as_float(p.y << 16), __uint_as_float(p.y & 0xffff0000u)};
                    const f32x4 h1 = {__uint_as_float(p.z << 16), __uint_as_float(p.z & 0xffff0000u), __uint_as_float(p.w << 16), __uint_as_float(p.w & 0xffff0000u)};
                    *(f32x4*)(out + off + bj * HALF) = h0 + acc[ai][bj][m][0]; *(f32x4*)(out + off + bj * HALF + 4) = h1 + acc[ai][bj][m][1]; } }
        }
        } else {
            float* pp = part + (size_t)(u.kt0 / u.nt) * (512 * 2048);
#pragma unroll
        for (int ai = 0; ai < 2; ++ai)
#pragma unroll
            for (int m = 0; m < 4; ++m) { const size_t off = (size_t)(row0 + ai * HALF + m * 16 - MROWS_PROMPT) * 2048 + col0;
#pragma unroll
                for (int bj = 0; bj < 2; ++bj) { *(f32x4*)(pp + off + bj * HALF) = acc[ai][bj][m][0]; *(f32x4*)(pp + off + bj * HALF + 4) = acc[ai][bj][m][1]; } }
        }
    }
};
template <class Epi, class Sched, bool ALIGN_EPI = false, bool SP2 = false>
__device__ __forceinline__ void gemm_phase(PG8_LAS unsigned char* lds, const Gemm g, const Sched& S, const Epi& E) {
    const int tid = threadIdx.x, wid = __builtin_amdgcn_readfirstlane(tid >> 6), lane = tid & 63, wr = wid >> 2, wc = wid & 3, fr = lane & 15, fq = lane >> 4;
    const int K = g.K;
    unsigned voffA[2], voffB[2];
#pragma unroll
    for (int i = 0; i < 2; ++i) { int R, C; stage_rc(tid * 16 + i * 8192, R, C); const int Rb = Epi::PERM ? ((R & ~31) + perm32(R & 31)) : R;
        voffA[i] = (unsigned)(R * (g.a_ktm ? BK : K) + C) * 2u; voffB[i] = (unsigned)(Rb * K + C) * 2u; }
    const size_t kstep = (size_t)(BK * 2);
    const size_t hstep = (size_t)HALF * K * 2;
    const size_t tstep = 2 * hstep;
    const size_t kstepA = g.a_ktm ? (size_t)g.M * BK * 2 : kstep, hstepA = g.a_ktm ? (size_t)HALF * BK * 2 : hstep, tstepA = 2 * hstepA;
    const unsigned ldsw = (unsigned)wid * 1024u;
    const int aoff = lds_byte(wr * 64 + fr, fq * 8), boff = lds_byte(wc * 32 + fr, fq * 8);
#define PG8_SA(b, h) (((b) * 2 + (h)) * HTB)
#define PG8_SB(b, h) ((4 + (b) * 2 + (h)) * HTB)
#define PG8_STAGE(bufoff, gbase, voff) do { _Pragma("unroll") for (int _i = 0; _i < 2; ++_i) \
        __builtin_amdgcn_global_load_lds((const unsigned*)((const char*)(gbase) + (voff)[_i]), (PG8_LAS unsigned*)(lds + (bufoff) + ldsw + _i * 8192), 16, 0, 0); } while (0)
#define PG8_LDA(dst, b, h) do { _Pragma("unroll") for (int m = 0; m < 4; ++m) _Pragma("unroll") for (int k = 0; k < 2; ++k) dst[m][k] = *(const PG8_LAS bf16x8*)(lds + PG8_SA(b, h) + aoff + m * 2048 + k * 1024); } while (0)
#define PG8_LDB(dst, b, h) do { _Pragma("unroll") for (int n = 0; n < 2; ++n) _Pragma("unroll") for (int k = 0; k < 2; ++k) dst[n][k] = *(const PG8_LAS bf16x8*)(lds + PG8_SB(b, h) + boff + n * 2048 + k * 1024); } while (0)
#define PG8_MMA(ai, bj, At, Bt) do { __builtin_amdgcn_s_setprio(1); _Pragma("unroll") for (int m = 0; m < 4; ++m) _Pragma("unroll") for (int n = 0; n < 2; ++n) _Pragma("unroll") for (int k = 0; k < 2; ++k) \
        acc[ai][bj][m][n] = __builtin_amdgcn_mfma_f32_16x16x32_bf16(Bt[n][k], At[m][k], acc[ai][bj][m][n], 0, 0, 0); __builtin_amdgcn_s_setprio(0); } while (0)
#define PG8_WAIT_V(n) asm volatile("s_waitcnt vmcnt(" #n ")" ::: "memory")
#define PG8_WAIT_L(n) asm volatile("s_waitcnt lgkmcnt(" #n ")" ::: "memory")
#define PG8_BAR __builtin_amdgcn_s_barrier()
#define PG8_SCHED __builtin_amdgcn_sched_barrier(0)
    Unit cur, nxt; int ui = 0;
    if (!S.next(0, cur)) return;
    f32x4 acc[2][2][4][2];
#pragma unroll
    for (int a = 0; a < 2; ++a)
#pragma unroll
        for (int b = 0; b < 2; ++b)
#pragma unroll
            for (int m = 0; m < 4; ++m)
#pragma unroll
                for (int n = 0; n < 2; ++n) acc[a][b][m][n] = (f32x4){0.f, 0.f, 0.f, 0.f};
    bf16x8 At[4][2], B0[2][2], B1[2][2];
    const char* cA = (const char*)g.A + (size_t)cur.pm * tstepA + (size_t)cur.kt0 * kstepA; const char* cB = (const char*)g.Bt + (size_t)cur.pn * tstep + (size_t)cur.kt0 * kstep;
    S.a_ready(cur);
    if constexpr (SP2) {
        PG8_STAGE(PG8_SB(0, 0), cB, voffB); PG8_STAGE(PG8_SB(0, 1), cB + hstep, voffB); PG8_STAGE(PG8_SA(0, 0), cA, voffA); PG8_STAGE(PG8_SA(0, 1), cA + hstepA, voffA);
        if (wr == 1) PG8_BAR;
        PG8_WAIT_V(2); PG8_BAR;
        PG8_STAGE(PG8_SB(1, 0), cB + kstep, voffB); PG8_STAGE(PG8_SA(1, 0), cA + kstepA, voffA); PG8_STAGE(PG8_SB(1, 1), cB + hstep + kstep, voffB);
        PG8_WAIT_V(6); PG8_BAR;
    } else {
        PG8_STAGE(PG8_SB(0, 0), cB, voffB); PG8_STAGE(PG8_SA(0, 0), cA, voffA); PG8_STAGE(PG8_SB(0, 1), cB + hstep, voffB); PG8_STAGE(PG8_SA(0, 1), cA + hstepA, voffA);
        if (wr == 1) PG8_BAR;
        PG8_WAIT_V(4); PG8_BAR;
        PG8_STAGE(PG8_SB(1, 0), cB + kstep, voffB); PG8_STAGE(PG8_SA(1, 0), cA + kstepA, voffA); PG8_STAGE(PG8_SB(1, 1), cB + hstep + kstep, voffB);
        PG8_WAIT_V(6); PG8_BAR;
    }
    for (;;) {
        const bool has_next = S.next(ui + 1, nxt);
        const char* nA = has_next ? (const char*)g.A + (size_t)nxt.pm * tstepA + (size_t)nxt.kt0 * kstepA : cA; const char* nB = has_next ? (const char*)g.Bt + (size_t)nxt.pn * tstep + (size_t)nxt.kt0 * kstep : cB;
        const int nt = cur.nt;
        for (int t = 0; t < nt; t += 2) {
            const bool last = (t == nt - 2);
            const char* a1 = cA + (size_t)(t + 1) * kstepA;
            const char* a2 = last ? nA : cA + (size_t)(t + 2) * kstepA; const char* b2 = last ? nB : cB + (size_t)(t + 2) * kstep;
            const char* a3 = a2 + kstepA; const char* b3 = b2 + kstep;
            if (last && has_next) S.a_ready(nxt);
            if constexpr (SP2) {
            PG8_LDB(B0, 0, 0); PG8_LDB(B1, 0, 1); PG8_SCHED; PG8_LDA(At, 0, 0); PG8_STAGE(PG8_SA(1, 1), a1 + hstepA, voffA);
            PG8_WAIT_V(8); PG8_WAIT_L(0); PG8_BAR; PG8_MMA(0, 0, At, B0); PG8_MMA(0, 1, At, B1); PG8_BAR; PG8_SCHED;
            PG8_LDA(At, 0, 1); PG8_STAGE(PG8_SB(0, 0), b2, voffB); PG8_STAGE(PG8_SB(0, 1), b2 + hstep, voffB); PG8_STAGE(PG8_SA(0, 0), a2, voffA);
            PG8_WAIT_V(8); PG8_WAIT_L(0); PG8_BAR; PG8_MMA(1, 0, At, B0); PG8_MMA(1, 1, At, B1); PG8_BAR; PG8_SCHED;
            PG8_LDB(B0, 1, 0); PG8_LDB(B1, 1, 1); PG8_SCHED; PG8_LDA(At, 1, 0); PG8_STAGE(PG8_SA(0, 1), a2 + hstepA, voffA);
            PG8_WAIT_V(8); PG8_WAIT_L(0); PG8_BAR; PG8_MMA(0, 0, At, B0); PG8_MMA(0, 1, At, B1); PG8_BAR; PG8_SCHED;
            PG8_LDA(At, 1, 1); PG8_STAGE(PG8_SB(1, 0), b3, voffB); PG8_STAGE(PG8_SB(1, 1), b3 + hstep, voffB); PG8_STAGE(PG8_SA(1, 0), a3, voffA);
            PG8_WAIT_V(8); PG8_WAIT_L(0); PG8_BAR; PG8_MMA(1, 0, At, B0); PG8_MMA(1, 1, At, B1); PG8_BAR; PG8_SCHED;
            } else {
            PG8_LDB(B0, 0, 0); PG8_SCHED; PG8_LDA(At, 0, 0); PG8_STAGE(PG8_SA(1, 1), a1 + hstepA, voffA);
            PG8_WAIT_L(8); PG8_BAR; PG8_WAIT_L(0); PG8_MMA(0, 0, At, B0); PG8_BAR; PG8_SCHED;
            PG8_LDB(B1, 0, 1); PG8_STAGE(PG8_SB(0, 0), b2, voffB);
            PG8_BAR; PG8_WAIT_L(0); PG8_MMA(0, 1, At, B1); PG8_BAR;
            PG8_LDA(At, 0, 1); PG8_STAGE(PG8_SA(0, 0), a2, voffA);
            PG8_BAR; PG8_WAIT_L(0); PG8_MMA(1, 0, At, B0); PG8_BAR; PG8_SCHED;
            PG8_STAGE(PG8_SB(0, 1), b2 + hstep, voffB);
            PG8_WAIT_V(6); PG8_BAR; PG8_MMA(1, 1, At, B1); PG8_BAR;
            PG8_LDB(B0, 1, 0); PG8_SCHED; PG8_LDA(At, 1, 0); PG8_STAGE(PG8_SA(0, 1), a2 + hstepA, voffA);
            PG8_WAIT_L(8); PG8_BAR; PG8_WAIT_L(0); PG8_MMA(0, 0, At, B0); PG8_BAR; PG8_SCHED;
            PG8_LDB(B1, 1, 1); PG8_STAGE(PG8_SB(1, 0), b3, voffB);
            PG8_BAR; PG8_WAIT_L(0); PG8_MMA(0, 1, At, B1); PG8_BAR;
            PG8_LDA(At, 1, 1); PG8_STAGE(PG8_SA(1, 0), a3, voffA);
            PG8_BAR; PG8_WAIT_L(0); PG8_MMA(1, 0, At, B0); PG8_BAR; PG8_SCHED;
            PG8_STAGE(PG8_SB(1, 1), b3 + hstep, voffB);
            PG8_WAIT_V(6); PG8_BAR; PG8_MMA(1, 1, At, B1); PG8_BAR;
            }
        }
        if constexpr (ALIGN_EPI) { if (wr == 0) PG8_BAR; }
        if constexpr (!Epi::AFTER_DRAIN) { E(acc, cur, wr, wc, fr, fq); S.done(cur); }
        if (!has_next) break;
#pragma unroll
        for (int a = 0; a < 2; ++a)
#pragma unroll
            for (int b = 0; b < 2; ++b)
#pragma unroll
                for (int m = 0; m < 4; ++m)
#pragma unroll
                    for (int n = 0; n < 2; ++n) acc[a][b][m][n] = (f32x4){0.f, 0.f, 0.f, 0.f};
        cur = nxt; cA = nA; cB = nB; ++ui;
        if constexpr (ALIGN_EPI) { if (wr == 1) PG8_BAR; }
    }
    PG8_WAIT_V(0);
    if constexpr (!ALIGN_EPI) { if (wr == 0) PG8_BAR; }
    PG8_BAR;
    if constexpr (Epi::AFTER_DRAIN) { E.fused(acc, cur, wr, wc, fr, fq, lds, wid, lane); S.done(cur); }
#undef PG8_SA
#undef PG8_SB
#undef PG8_STAGE
#undef PG8_LDA
#undef PG8_LDB
#undef PG8_MMA
#undef PG8_WAIT_V
#undef PG8_WAIT_L
#undef PG8_BAR
#undef PG8_SCHED
}
}

#ifndef MK_N_LAUNCHES
#define MK_N_LAUNCHES 1
#endif
#ifndef PROBE_SEQ
#define PROBE_SEQ {0, 1, 2, 3, 4, 5, 6, 7, 8, 9, 10}
#endif
#define DI __device__ __forceinline__
#define LAS __attribute__((address_space(3)))
typedef unsigned short bf16;
typedef short bf16x8 __attribute__((ext_vector_type(8)));
typedef float f32x4 __attribute__((ext_vector_type(4)));
typedef float f32x2 __attribute__((ext_vector_type(2)));
typedef unsigned u32x4 __attribute__((ext_vector_type(4)));
typedef unsigned u32x2 __attribute__((ext_vector_type(2)));

constexpr int NPH = 11;
constexpr int MP = 16384, MS = 512, MT = 16896, DM = 2048, PW = 4352, DFF = 5632;
constexpr float LOG2E = 1.4426950408889634f;
constexpr size_t MiB = 1u << 20;
constexpr size_t WS_TABC = 1 * MiB, WS_TABS = 2 * MiB, WS_SSQ = 3 * MiB;
constexpr size_t WS_WUP = 4 * MiB, WS_WDN = 48 * MiB, WS_HB = 70 * MiB;
constexpr size_t WS_G = 136 * MiB, WS_U = WS_G + (size_t)MT * DFF * 2, WS_END = WS_U + (size_t)MT * DFF * 2;
constexpr size_t WS_WIN = 136 * MiB, WS_WO = 153 * MiB, WS_PROJ = 161 * MiB, WS_CAT = 302 * MiB, WS_LBUF = 368 * MiB, WS_SBUF = 400 * MiB;
static_assert(WS_PROJ + (size_t)MT * PW * 2 <= WS_CAT && WS_SBUF + 16 * MiB <= WS_END, "ws map");
constexpr size_t WS_PART = 161 * MiB;
constexpr int KSPLIT = 11;
constexpr size_t WS_GSB = 136 * MiB, WS_USB = 142 * MiB, WS_GHF = 148 * MiB, WS_UHF = 151 * MiB, WS_GHL = 154 * MiB;
constexpr size_t OFF_Y = 0, OFF_RET_P = (size_t)MT * DM, OFF_RET_S = OFF_RET_P + 262144, OFF_SWAK_P = OFF_RET_S + 8388608, OFF_SWAK_S = OFF_SWAK_P + 65536,
                 OFF_SWAV_P = OFF_SWAK_S + 2097152, OFF_SWAV_S = OFF_SWAV_P + 65536, OFF_CONV_P = OFF_SWAV_S + 2097152, OFF_CONV_S = OFF_CONV_P + 45056, OUT_TOTAL = OFF_CONV_S + 1441792;
constexpr int LDS_BYTES = 147456;

struct Params {
    const float *x_prompt, *x_sample, *state_ret, *cache_k, *cache_v, *state_conv, *attn_norm_w, *w_in, *q_norm_w, *k_norm_w, *sinks, *gn_w, *w_o, *ffn_norm_w, *w_up, *conv_w, *conv_b, *w_down;
    float* out; unsigned char* ws;
    float inv_freq[32]; float lg2[8];
    int ph_lo, ph_hi, dummy, pad;
};

DI float bf_lo(unsigned v) { return __uint_as_float(v << 16); }
DI float bf_hi(unsigned v) { return __uint_as_float(v & 0xffff0000u); }
DI unsigned pk2(float lo, float hi) { return pg8::cvt_pk_bf16(lo, hi); }
DI unsigned short f2bf(float f) { return (unsigned short)(pk2(f, f) & 0xffffu); }
DI void unpack8(const u32x4 v, float (&f)[8]) { f[0] = bf_lo(v.x); f[1] = bf_hi(v.x); f[2] = bf_lo(v.y); f[3] = bf_hi(v.y); f[4] = bf_lo(v.z); f[5] = bf_hi(v.z); f[6] = bf_lo(v.w); f[7] = bf_hi(v.w); }
DI u32x4 pack8(const float (&f)[8]) { u32x4 r; r.x = pk2(f[0], f[1]); r.y = pk2(f[2], f[3]); r.z = pk2(f[4], f[5]); r.w = pk2(f[6], f[7]); return r; }
DI bf16x8 as_bf16x8(u32x4 v) { return __builtin_bit_cast(bf16x8, v); }
DI float wave_sum(float v) {
#pragma unroll
    for (int o = 1; o < 64; o <<= 1) v += __shfl_xor(v, o);
    return v;
}
DI f32x4 mfma16(bf16x8 a, bf16x8 b, f32x4 c) { return __builtin_amdgcn_mfma_f32_16x16x32_bf16(a, b, c, 0, 0, 0); }
DI float ex2(float x) { return __builtin_amdgcn_exp2f(x); }
DI float silu(float x) { return x * __builtin_amdgcn_rcpf(1.0f + __expf(-x)); }
DI float sel_lg2(const Params& P, int h) { float r = P.lg2[0];
#pragma unroll
    for (int k = 1; k < 8; ++k) r = (h == k) ? P.lg2[k] : r;
    return r; }
#define LDS_WAIT() asm volatile("s_waitcnt lgkmcnt(0)" ::: "memory")

DI void p0_transpose_item(const float* W, int K, int N, bf16* WT, LAS float* scr, int item, int lane, const float* kscale, bool upmap) {
    const int nblk = N / 32, kb = item / nblk, nb = item % nblk, k0 = 64 * kb, n0 = 32 * nb;
    const int r0 = !upmap ? n0 : (n0 < DFF ? (n0 / 128) * 256 + (n0 % 128) : ((n0 - DFF) / 128) * 256 + 128 + ((n0 - DFF) % 128));
    f32x4 v[8];
#pragma unroll
    for (int i = 0; i < 8; ++i) { const int kk = 8 * i + (lane >> 3); v[i] = __builtin_nontemporal_load((const f32x4*)(W + (size_t)(k0 + kk) * N + n0 + 4 * (lane & 7))); }
#pragma unroll
    for (int i = 0; i < 8; ++i) { const int kk = 8 * i + (lane >> 3); f32x4 t = v[i]; if (kscale) t = t * kscale[k0 + kk]; LAS float* d = scr + kk * 33 + 4 * (lane & 7); d[0] = t[0]; d[1] = t[1]; d[2] = t[2]; d[3] = t[3]; }
    LDS_WAIT();
    const int c = lane & 7;
#pragma unroll
    for (int j = 0; j < 4; ++j) { const int n = (lane >> 3) + 8 * j; const LAS float* s = scr + (8 * c) * 33 + n;
        u32x4 o; o.x = pk2(s[0 * 33], s[1 * 33]); o.y = pk2(s[2 * 33], s[3 * 33]); o.z = pk2(s[4 * 33], s[5 * 33]); o.w = pk2(s[6 * 33], s[7 * 33]);
        *(u32x4*)(WT + (size_t)(r0 + n) * K + k0 + 8 * c) = o; }
    LDS_WAIT();
}
DI void rms_row_to_bf16(const float* xrow, const float* w, bf16* orow, int lane) {
    const f32x4* xr = (const f32x4*)xrow + lane; const f32x4* wr = (const f32x4*)w + lane;
    f32x4 v[8]; float s = 0.f;
#pragma unroll
    for (int j = 0; j < 8; ++j) { v[j] = xr[64 * j]; s += (v[j].x * v[j].x + v[j].y * v[j].y) + (v[j].z * v[j].z + v[j].w * v[j].w); }
    const float rstd = 1.0f / sqrtf(wave_sum(s) * (1.0f / 2048.0f) + 1e-6f);
#pragma unroll
    for (int j = 0; j < 8; ++j) { const f32x4 ww = wr[64 * j]; const f32x4 o = v[j] * rstd * ww; u32x2 pk; pk.x = pk2(o.x, o.y); pk.y = pk2(o.z, o.w); *(u32x2*)(orow + 4 * lane + 256 * j) = pk; }
}
DI void p0_prologue(const Params& P, LAS unsigned char* lds, int tid, int lane, int w) {
    LAS float* scr = (LAS float*)(lds + w * 16384);
    const int gw = blockIdx.x * 8 + w, NGW = gridDim.x * 8;
    bf16* wt_in = (bf16*)(P.ws + WS_WIN); bf16* wt_o = (bf16*)(P.ws + WS_WO);
    constexpr int I_IN = (DM / 64) * (PW / 32), I_O = (DM / 64) * (DM / 32);
    constexpr int NITEMS = I_IN + I_O;
    for (int it = gw; it < NITEMS; it += NGW) {
        if (it < I_IN) p0_transpose_item(P.w_in, DM, PW, wt_in, scr, it, lane, nullptr, false);
        else p0_transpose_item(P.w_o, DM, DM, wt_o, scr, it - I_IN, lane, nullptr, false);
    }
    bf16* a1 = (bf16*)(P.ws + WS_HB);
    for (int m = gw; m < MT; m += 2 * NGW) {
        const int m2 = m + NGW; const bool has2 = m2 < MT; const int mb = has2 ? m2 : m;
        const f32x4* xa = (const f32x4*)(m < MP ? P.x_prompt + (size_t)m * DM : P.x_sample + (size_t)(m - MP) * DM) + lane;
        const f32x4* xb = (const f32x4*)(mb < MP ? P.x_prompt + (size_t)mb * DM : P.x_sample + (size_t)(mb - MP) * DM) + lane;
        const f32x4* wr = (const f32x4*)P.attn_norm_w + lane;
        f32x4 va[8], vb[8]; float sa = 0.f, sb = 0.f;
#pragma unroll
        for (int j = 0; j < 8; ++j) { va[j] = __builtin_nontemporal_load(xa + 64 * j); vb[j] = __builtin_nontemporal_load(xb + 64 * j); }
#pragma unroll
        for (int j = 0; j < 8; ++j) { sa += (va[j].x * va[j].x + va[j].y * va[j].y) + (va[j].z * va[j].z + va[j].w * va[j].w); sb += (vb[j].x * vb[j].x + vb[j].y * vb[j].y) + (vb[j].z * vb[j].z + vb[j].w * vb[j].w); }
        const float ra = 1.0f / sqrtf(wave_sum(sa) * (1.0f / 2048.0f) + 1e-6f), rb = 1.0f / sqrtf(wave_sum(sb) * (1.0f / 2048.0f) + 1e-6f);
#pragma unroll
        for (int j = 0; j < 8; ++j) { const f32x4 ww = wr[64 * j]; const f32x4 oa = va[j] * ra * ww, ob = vb[j] * rb * ww; u32x2 pa, pb; pa.x = pk2(oa.x, oa.y); pa.y = pk2(oa.z, oa.w); pb.x = pk2(ob.x, ob.y); pb.y = pk2(ob.z, ob.w);
            *(u32x2*)(a1 + (size_t)m * DM + 4 * lane + 256 * j) = pa; if (has2) *(u32x2*)(a1 + (size_t)m2 * DM + 4 * lane + 256 * j) = pb; }
    }
    float* tabc = (float*)(P.ws + WS_TABC); float* tabs = (float*)(P.ws + WS_TABS); float* ssq = (float*)(P.ws + WS_SSQ);
    const int gt = blockIdx.x * 512 + tid, NGT = gridDim.x * 512;
    for (int idx = gt; idx < 4100 * 32; idx += NGT) { const int p = idx >> 5, i = idx & 31; const int pos = p < 4096 ? p : 16384 + (p - 4096);
        float inv = P.inv_freq[0];
#pragma unroll
        for (int k = 1; k < 32; ++k) inv = (i == k) ? P.inv_freq[k] : inv;
        const float ang = (float)pos * inv; const double rev = (double)ang * 0.15915494309189535; const float fr = (float)(rev - floor(rev));
        tabc[idx] = __builtin_amdgcn_cosf(fr); tabs[idx] = __builtin_amdgcn_sinf(fr); }
    for (int idx = gt; idx < MT; idx += NGT) ssq[idx] = 0.f;
}

struct RopeIn { u32x4 a, c; f32x4 c0, c1, s0, s1; };
DI RopeIn rope_load(const bf16* proj, const float* tabc, const float* tabs, size_t row, int tok, int col0, int qq) {
    RopeIn in; const bf16* p = proj + row * PW + col0 + 8 * qq; in.a = *(const u32x4*)p; in.c = *(const u32x4*)(p + 32);
    const float* tc = tabc + tok * 32 + 8 * qq; const float* ts = tabs + tok * 32 + 8 * qq;
    in.c0 = *(const f32x4*)tc; in.c1 = *(const f32x4*)(tc + 4); in.s0 = *(const f32x4*)ts; in.s1 = *(const f32x4*)(ts + 4); return in;
}
DI void rope_apply(const RopeIn& in, float scale, float (&o1)[8], float (&o2)[8]) {
    float x1[8], x2[8]; unpack8(in.a, x1); unpack8(in.c, x2);
#pragma unroll
    for (int e = 0; e < 8; ++e) { const float c = e < 4 ? in.c0[e & 3] : in.c1[e & 3], s = e < 4 ? in.s0[e & 3] : in.s1[e & 3]; o1[e] = (x1[e] * c - x2[e] * s) * scale; o2[e] = (x2[e] * c + x1[e] * s) * scale; }
}

DI void tail_transposes(const Params& P, LAS unsigned char* lds, int nunits, int slot, int lane, int w) {
    const int G = gridDim.x, rem = nunits % G; const int first = rem, nidle = G - rem;
    if ((int)blockIdx.x < first) return;
    LAS float* scr = (LAS float*)(lds + w * 16384);
    const int gw = ((int)blockIdx.x - first) * 8 + w, NGW = nidle * 8;
    bf16* wt_up = (bf16*)(P.ws + WS_WUP); bf16* wt_dn = (bf16*)(P.ws + WS_WDN);
    constexpr int I_UP = (DM / 64) * (2 * DFF / 32), I_DN = (DFF / 64) * (DM / 32), I_UP_A = 8000;
    if (slot == 0) { for (int it = gw; it < I_UP_A; it += NGW) p0_transpose_item(P.w_up, DM, 2 * DFF, wt_up, scr, it, lane, P.ffn_norm_w, true); }
    else if (slot == 1) { for (int it = gw; it < I_UP - I_UP_A; it += NGW) p0_transpose_item(P.w_up, DM, 2 * DFF, wt_up, scr, I_UP_A + it, lane, P.ffn_norm_w, true); }
    else { for (int it = gw; it < I_DN; it += NGW) p0_transpose_item(P.w_down, DFF, DM, wt_dn, scr, it, lane, nullptr, false); }
}

DI void swa_prompt_unit(const Params& P, LAS unsigned char* lds, int unit, int tid, int lane, int w) {
    const bf16* proj = (const bf16*)(P.ws + WS_PROJ); const float* tabc = (const float*)(P.ws + WS_TABC); const float* tabs = (const float*)(P.ws + WS_TABS); bf16* cat = (bf16*)(P.ws + WS_CAT);
    const int qb = unit & 31, kvh = (unit >> 5) & 1, b = unit >> 6;
    LAS unsigned char* KS = lds;
    LAS unsigned char* VT = lds + 36864;
    const int l15 = lane & 15, quad = lane >> 4; const int hh = kvh * 8 + w;
    {
        const int key = tid >> 1, half = tid & 1; const int tok = 128 * (qb - 1) + key;
        float o1a[8], o1b[8], o2a[8], o2b[8]; u32x4 vr[4];
        if (tok >= 0) {
            const size_t row = (size_t)b * 4096 + tok; const bf16* p = proj + row * PW + 4096 + kvh * 64 + 16 * half;
            const u32x4 a0 = *(const u32x4*)p, a1 = *(const u32x4*)(p + 8), b0 = *(const u32x4*)(p + 32), b1 = *(const u32x4*)(p + 40);
            float x1a[8], x1b[8], x2a[8], x2b[8]; unpack8(a0, x1a); unpack8(a1, x1b); unpack8(b0, x2a); unpack8(b1, x2b);
            float ss = 0.f;
#pragma unroll
            for (int e = 0; e < 8; ++e) ss += x1a[e] * x1a[e] + x1b[e] * x1b[e] + x2a[e] * x2a[e] + x2b[e] * x2b[e];
            ss += __shfl_xor(ss, 1);
            const float rstd = 1.0f / sqrtf(ss * (1.0f / 64.0f) + 1e-6f);
            float kw[48], tc[16], ts[16];
#pragma unroll
            for (int k4 = 0; k4 < 4; ++k4) { const f32x4 a = *(const f32x4*)(P.k_norm_w + 16 * half + 4 * k4), b2 = *(const f32x4*)(P.k_norm_w + 32 + 16 * half + 4 * k4), c4 = *(const f32x4*)(tabc + tok * 32 + 16 * half + 4 * k4), s4 = *(const f32x4*)(tabs + tok * 32 + 16 * half + 4 * k4);
#pragma unroll
                for (int e = 0; e < 4; ++e) { kw[4 * k4 + e] = a[e]; kw[32 + 4 * k4 + e] = b2[e]; tc[4 * k4 + e] = c4[e]; ts[4 * k4 + e] = s4[e]; } }
#pragma unroll
            for (int e = 0; e < 8; ++e) {
                { const float n1 = x1a[e] * rstd * kw[e], n2 = x2a[e] * rstd * kw[32 + e], c = tc[e], s = ts[e]; o1a[e] = n1 * c - n2 * s; o2a[e] = n2 * c + n1 * s; }
                { const float n1 = x1b[e] * rstd * kw[8 + e], n2 = x2b[e] * rstd * kw[40 + e], c = tc[8 + e], s = ts[8 + e]; o1b[e] = n1 * c - n2 * s; o2b[e] = n2 * c + n1 * s; } }
            const bf16* pv = proj + row * PW + 4224 + kvh * 64 + 32 * half;
#pragma unroll
            for (int k = 0; k < 4; ++k) vr[k] = *(const u32x4*)(pv + 8 * k);
            if (qb == 31 && key >= 128) {
                float* ok = P.out + OFF_SWAK_P + ((size_t)(b * 128 + key - 128) * 2 + kvh) * 64; float* ov = P.out + OFF_SWAV_P + ((size_t)(b * 128 + key - 128) * 2 + kvh) * 64;
#pragma unroll
                for (int e = 0; e < 8; ++e) { ok[16 * half + e] = o1a[e]; ok[16 * half + 8 + e] = o1b[e]; ok[32 + 16 * half + e] = o2a[e]; ok[32 + 16 * half + 8 + e] = o2b[e]; }
#pragma unroll
                for (int k = 0; k < 4; ++k) { float f[8]; unpack8(vr[k], f);
#pragma unroll
                    for (int e = 0; e < 8; ++e) ov[32 * half + 8 * k + e] = f[e]; }
            }
        } else {
#pragma unroll
            for (int e = 0; e < 8; ++e) { o1a[e] = 0.f; o1b[e] = 0.f; o2a[e] = 0.f; o2b[e] = 0.f; }
#pragma unroll
            for (int k = 0; k < 4; ++k) vr[k] = (u32x4){0u, 0u, 0u, 0u};
        }
        LAS unsigned char* kp = KS + key * 144 + half * 32;
        *(LAS u32x4*)(kp) = pack8(o1a); *(LAS u32x4*)(kp + 16) = pack8(o1b); *(LAS u32x4*)(kp + 64) = pack8(o2a); *(LAS u32x4*)(kp + 80) = pack8(o2b);
#pragma unroll
        for (int k = 0; k < 4; ++k) { const unsigned wv[4] = {vr[k].x, vr[k].y, vr[k].z, vr[k].w};
#pragma unroll
            for (int e = 0; e < 4; ++e) { const int d = 32 * half + 8 * k + 2 * e;
                *(LAS unsigned short*)(VT + d * 544 + key * 2) = (unsigned short)(wv[e] & 0xffffu); *(LAS unsigned short*)(VT + (d + 1) * 544 + key * 2) = (unsigned short)(wv[e] >> 16); } }
    }
    RopeIn qnext = rope_load(proj, tabc, tabs, (size_t)b * 4096 + 128 * qb + l15, 128 * qb + l15, 3072 + hh * 64, quad);
    float qw1[8], qw2[8];
    { const f32x4 a0 = *(const f32x4*)(P.q_norm_w + 8 * quad), a1 = *(const f32x4*)(P.q_norm_w + 8 * quad + 4), b0 = *(const f32x4*)(P.q_norm_w + 32 + 8 * quad), b1 = *(const f32x4*)(P.q_norm_w + 36 + 8 * quad);
#pragma unroll
      for (int e = 0; e < 4; ++e) { qw1[e] = a0[e]; qw1[4 + e] = a1[e]; qw2[e] = b0[e]; qw2[4 + e] = b1[e]; } }
    __syncthreads();
    {
        const float sink2 = P.sinks[hh] * LOG2E; const float qscale = 0.125f * LOG2E;
#pragma unroll 2
        for (int qt = 0; qt < 8; ++qt) {
            const int i = 16 * qt + l15; const int tok = 128 * qb + i; const size_t row = (size_t)b * 4096 + tok;
            const RopeIn qin = qnext;
            if (qt < 7) qnext = rope_load(proj, tabc, tabs, row + 16, tok + 16, 3072 + hh * 64, quad);
            float x1[8], x2[8], o1[8], o2[8]; unpack8(qin.a, x1); unpack8(qin.c, x2);
            float ss = 0.f;
#pragma unroll
            for (int e = 0; e < 8; ++e) ss += x1[e] * x1[e] + x2[e] * x2[e];
            ss += __shfl_xor(ss, 16); ss += __shfl_xor(ss, 32);
            const float rstd = qscale / sqrtf(ss * (1.0f / 64.0f) + 1e-6f);
#pragma unroll
            for (int e = 0; e < 8; ++e) { const float n1 = x1[e] * rstd * qw1[e], n2 = x2[e] * rstd * qw2[e], c = e < 4 ? qin.c0[e & 3] : qin.c1[e & 3], s = e < 4 ? qin.s0[e & 3] : qin.s1[e & 3]; o1[e] = n1 * c - n2 * s; o2[e] = n2 * c + n1 * s; }
            const bf16x8 qf0 = as_bf16x8(pack8(o1)), qf1 = as_bf16x8(pack8(o2));
            f32x4 acc[10];
#pragma unroll
            for (int tt = 0; tt < 9; ++tt) { int jt = qt + tt; jt = jt > 15 ? 15 : jt;
                const LAS unsigned char* kp = KS + (16 * jt + l15) * 144 + quad * 16;
                const bf16x8 k0 = *(const LAS bf16x8*)kp, k1 = *(const LAS bf16x8*)(kp + 64);
                f32x4 z = {0.f, 0.f, 0.f, 0.f}; z = mfma16(k0, qf0, z); acc[tt] = mfma16(k1, qf1, z); }
            acc[9] = (f32x4){0.f, 0.f, 0.f, 0.f};
            float mx = -INFINITY;
#pragma unroll
            for (int tt = 0; tt < 9; ++tt)
#pragma unroll
                for (int e = 0; e < 4; ++e) { const int kidx = 16 * (qt + tt) + 4 * quad + e; const bool valid = (kidx >= i) && (kidx <= i + 128) && (qb > 0 || kidx >= 128);
                    const float sv = valid ? acc[tt][e] : -INFINITY; acc[tt][e] = sv; mx = fmaxf(mx, sv); }
            mx = fmaxf(mx, __shfl_xor(mx, 16)); mx = fmaxf(mx, __shfl_xor(mx, 32));
            const float m = fmaxf(mx, sink2); float sum = 0.f;
#pragma unroll
            for (int tt = 0; tt < 9; ++tt)
#pragma unroll
                for (int e = 0; e < 4; ++e) { const float pe = ex2(acc[tt][e] - m); acc[tt][e] = pe; sum += pe; }
            sum += __shfl_xor(sum, 16); sum += __shfl_xor(sum, 32);
            const float inv = 1.0f / (sum + ex2(sink2 - m));
            f32x4 o[4];
#pragma unroll
            for (int dt = 0; dt < 4; ++dt) o[dt] = (f32x4){0.f, 0.f, 0.f, 0.f};
#pragma unroll
            for (int pp = 0; pp < 5; ++pp) {
                u32x4 pw; pw.x = pk2(acc[2 * pp][0], acc[2 * pp][1]); pw.y = pk2(acc[2 * pp][2], acc[2 * pp][3]); pw.z = pk2(acc[2 * pp + 1][0], acc[2 * pp + 1][1]); pw.w = pk2(acc[2 * pp + 1][2], acc[2 * pp + 1][3]);
                const bf16x8 pf = as_bf16x8(pw);
                int ja = qt + 2 * pp; ja = ja > 15 ? 15 : ja; int jb = qt + 2 * pp + 1; jb = jb > 15 ? 15 : jb;
#pragma unroll
                for (int dt = 0; dt < 4; ++dt) { const LAS unsigned char* vp = VT + (16 * dt + l15) * 544 + quad * 8;
                    const u32x2 va = *(const LAS u32x2*)(vp + ja * 32), vb = *(const LAS u32x2*)(vp + jb * 32);
                    const bf16x8 vf = as_bf16x8((u32x4){va.x, va.y, vb.x, vb.y}); o[dt] = mfma16(vf, pf, o[dt]); } }
#pragma unroll
            for (int dt = 0; dt < 4; ++dt) { bf16* op = cat + row * DM + 1024 + hh * 64 + 16 * dt + 4 * quad; u32x2 pk; pk.x = pk2(o[dt][0] * inv, o[dt][1] * inv); pk.y = pk2(o[dt][2] * inv, o[dt][3] * inv); *(u32x2*)op = pk; }
        }
    }
    __syncthreads();
}

DI void ret_stage_vt(const bf16* proj, LAS unsigned char* VT, size_t row0, int h, int tid) {
    const int j = tid >> 2, qq = tid & 3; const bf16* pv = proj + (row0 + j) * PW + 1024 + h * 128 + 32 * qq;
#pragma unroll
    for (int k = 0; k < 4; ++k) { const u32x4 v = *(const u32x4*)(pv + 8 * k); const unsigned wv[4] = {v.x, v.y, v.z, v.w};
#pragma unroll
        for (int e = 0; e < 4; ++e) { const int d = 32 * qq + 8 * k + 2 * e;
            *(LAS unsigned short*)(VT + d * 272 + j * 2) = (unsigned short)(wv[e] & 0xffffu); *(LAS unsigned short*)(VT + (d + 1) * 272 + j * 2) = (unsigned short)(wv[e] >> 16); } }
}
DI void ret_rope_k(const bf16* proj, const float* tabc, const float* tabs, size_t row, int tok, int col0, int qq, float scale, float (&o1)[8], float (&o2)[8]) {
    const RopeIn in = rope_load(proj, tabc, tabs, row, tok, col0, qq); rope_apply(in, scale, o1, o2);
}

DI void ret_l_unit(const Params& P, LAS unsigned char* lds0, int unit, int tid, int lane, int w, int buf) {
    LAS unsigned char* lds = lds0 + buf * 53248;
    const bf16* proj = (const bf16*)(P.ws + WS_PROJ); const float* tabc = (const float*)(P.ws + WS_TABC); const float* tabs = (const float*)(P.ws + WS_TABS); float* lbuf = (float*)(P.ws + WS_LBUF);
    const int c = unit & 31, h = (unit >> 5) & 7, b = unit >> 8; const float lg = sel_lg2(P, h);
    LAS unsigned char* KT = lds;
    LAS unsigned char* VT = lds + 17408;
    const size_t row0 = (size_t)b * 4096 + 128 * c;
    {
        const int j = tid >> 2, qq = tid & 3; float o1[8], o2[8];
        ret_rope_k(proj, tabc, tabs, row0 + j, 128 * c + j, 512 + h * 64, qq, 0.125f * ex2((float)(127 - j) * lg), o1, o2);
#pragma unroll
        for (int e = 0; e < 8; ++e) { *(LAS unsigned short*)(KT + (8 * qq + e) * 272 + j * 2) = f2bf(o1[e]); *(LAS unsigned short*)(KT + (32 + 8 * qq + e) * 272 + j * 2) = f2bf(o2[e]); }
        ret_stage_vt(proj, VT, row0, h, tid);
    }
    __syncthreads();
    {
        const int l15 = lane & 15, quad = lane >> 4;
        f32x4 acc[4];
#pragma unroll
        for (int kt = 0; kt < 4; ++kt) acc[kt] = (f32x4){0.f, 0.f, 0.f, 0.f};
#pragma unroll
        for (int s = 0; s < 4; ++s) { const bf16x8 vf = *(const LAS bf16x8*)(VT + (16 * w + l15) * 272 + (32 * s + 8 * quad) * 2);
#pragma unroll
            for (int kt = 0; kt < 4; ++kt) { const bf16x8 kf = *(const LAS bf16x8*)(KT + (16 * kt + l15) * 272 + (32 * s + 8 * quad) * 2); acc[kt] = mfma16(kf, vf, acc[kt]); } }
        float* lp = lbuf + (size_t)unit * 8192 + (16 * w + l15) * 64 + 4 * quad;
#pragma unroll
        for (int kt = 0; kt < 4; ++kt) *(f32x4*)(lp + 16 * kt) = acc[kt];
    }
}

DI void ret_scan(const Params& P, int tid) {
    const float* __restrict__ lbuf = (const float*)(P.ws + WS_LBUF); unsigned* __restrict__ sbuf = (unsigned*)(P.ws + WS_SBUF);
    for (int idx = blockIdx.x * 512 + tid; idx < 32 * 4096; idx += gridDim.x * 512) {
        const int bh = idx >> 12, e2 = idx & 4095; const float g128 = ex2(128.0f * sel_lg2(P, bh & 7));
        const size_t o0 = (size_t)(bh * 32) * 8192 + 2 * e2;
        f32x2 l[32];
#pragma unroll
        for (int c = 0; c < 32; ++c) l[c] = *(const f32x2*)(lbuf + o0 + (size_t)c * 8192);
        float s0 = 0.f, s1 = 0.f;
#pragma unroll
        for (int c = 0; c < 32; ++c) { sbuf[(o0 + (size_t)c * 8192) >> 1] = pk2(s0, s1); s0 = s0 * g128 + l[c].x; s1 = s1 * g128 + l[c].y; }
        const int dv = (2 * e2) >> 6, dk = (2 * e2) & 63; float* op = P.out + OFF_RET_P + ((size_t)bh * 64 + dk) * 128 + dv; op[0] = s0; op[128] = s1;
    }
}

DI void ret_c_unit(const Params& P, LAS unsigned char* lds0, int unit, int tid, int lane, int w, int buf, float (&S)[16], float g128) {
    LAS unsigned char* lds = lds0 + buf * 71680;
    LAS unsigned char* SL = lds + 53248;
    const bf16* proj = (const bf16*)(P.ws + WS_PROJ); const float* tabc = (const float*)(P.ws + WS_TABC); const float* tabs = (const float*)(P.ws + WS_TABS);
    const float* lbuf = (const float*)(P.ws + WS_LBUF); bf16* cat = (bf16*)(P.ws + WS_CAT);
    const int c = unit & 31, h = (unit >> 5) & 7, b = unit >> 8; const float lg = sel_lg2(P, h);
    LAS unsigned char* KS = lds;
    LAS unsigned char* VT = lds + 18432;
    const size_t row0 = (size_t)b * 4096 + 128 * c;
    const int l15 = lane & 15, quad = lane >> 4; const int il = 16 * w + l15; const size_t row = row0 + il;
    const RopeIn qin = rope_load(proj, tabc, tabs, row, 128 * c + il, h * 64, quad);
    const int sdv = tid >> 2, sdk = (tid & 3) * 16;
    {
        const int j = tid >> 2, qq = tid & 3; float o1[8], o2[8];
        ret_rope_k(proj, tabc, tabs, row0 + j, 128 * c + j, 512 + h * 64, qq, 0.125f, o1, o2);
        *(LAS u32x4*)(KS + j * 144 + qq * 16) = pack8(o1); *(LAS u32x4*)(KS + j * 144 + 64 + qq * 16) = pack8(o2);
        ret_stage_vt(proj, VT, row0, h, tid);
        { float s0[8], s1[8];
#pragma unroll
          for (int e = 0; e < 8; ++e) { s0[e] = S[e]; s1[e] = S[8 + e]; }
          *(LAS u32x4*)(SL + sdv * 144 + sdk * 2) = pack8(s0); *(LAS u32x4*)(SL + sdv * 144 + sdk * 2 + 16) = pack8(s1); }
    }
    __syncthreads();
    {
        float q1[8], q2[8]; rope_apply(qin, 1.0f, q1, q2);
        const bf16x8 qf0 = as_bf16x8(pack8(q1)), qf1 = as_bf16x8(pack8(q2));
        f32x4 acc[8];
#pragma unroll
        for (int vt = 0; vt < 8; ++vt) { const LAS unsigned char* sp = SL + (16 * vt + l15) * 144 + quad * 16; const bf16x8 s0 = *(const LAS bf16x8*)sp, s1 = *(const LAS bf16x8*)(sp + 64);
            f32x4 z = {0.f, 0.f, 0.f, 0.f}; z = mfma16(s0, qf0, z); acc[vt] = mfma16(s1, qf1, z); }
        const float rowdec = ex2((float)(il + 1) * lg);
#pragma unroll
        for (int vt = 0; vt < 8; ++vt) acc[vt] = acc[vt] * rowdec;
        f32x4 sc[8];
#pragma unroll
        for (int jt = 0; jt < 8; ++jt) {
            if (jt <= w) { const LAS unsigned char* kp = KS + (16 * jt + l15) * 144 + quad * 16; const bf16x8 k0 = *(const LAS bf16x8*)kp, k1 = *(const LAS bf16x8*)(kp + 64);
                f32x4 z = {0.f, 0.f, 0.f, 0.f}; z = mfma16(k0, qf0, z); z = mfma16(k1, qf1, z);
#pragma unroll
                for (int e = 0; e < 4; ++e) { const int diff = il - (16 * jt + 4 * quad + e); z[e] = diff >= 0 ? z[e] * ex2((float)diff * lg) : 0.f; }
                sc[jt] = z; }
            else sc[jt] = (f32x4){0.f, 0.f, 0.f, 0.f};
        }
#pragma unroll
        for (int pp = 0; pp < 4; ++pp) {
            if (2 * pp <= w) {
                u32x4 pw; pw.x = pk2(sc[2 * pp][0], sc[2 * pp][1]); pw.y = pk2(sc[2 * pp][2], sc[2 * pp][3]); pw.z = pk2(sc[2 * pp + 1][0], sc[2 * pp + 1][1]); pw.w = pk2(sc[2 * pp + 1][2], sc[2 * pp + 1][3]);
                const bf16x8 pf = as_bf16x8(pw);
#pragma unroll
                for (int vt = 0; vt < 8; ++vt) { const LAS unsigned char* vp = VT + (16 * vt + l15) * 272 + quad * 8;
                    const u32x2 va = *(const LAS u32x2*)(vp + (2 * pp) * 32), vb = *(const LAS u32x2*)(vp + (2 * pp + 1) * 32);
                    acc[vt] = mfma16(as_bf16x8((u32x4){va.x, va.y, vb.x, vb.y}), pf, acc[vt]); } }
        }
        float sum = 0.f;
#pragma unroll
        for (int vt = 0; vt < 8; ++vt) sum += (acc[vt][0] + acc[vt][1]) + (acc[vt][2] + acc[vt][3]);
        sum += __shfl_xor(sum, 16); sum += __shfl_xor(sum, 32);
        const float mu = sum * (1.0f / 128.0f); float var = 0.f;
#pragma unroll
        for (int vt = 0; vt < 8; ++vt) { acc[vt] = acc[vt] - mu; var += (acc[vt][0] * acc[vt][0] + acc[vt][1] * acc[vt][1]) + (acc[vt][2] * acc[vt][2] + acc[vt][3] * acc[vt][3]); }
        var += __shfl_xor(var, 16); var += __shfl_xor(var, 32);
        const float rstd = 1.0f / sqrtf(var * (1.0f / 128.0f) + 1e-6f);
#pragma unroll
        for (int vt = 0; vt < 8; ++vt) { const int dv0 = 16 * vt + 4 * quad; const u32x2 gr = *(const u32x2*)(proj + row * PW + 2048 + h * 128 + dv0); const f32x4 gw = *(const f32x4*)(P.gn_w + h * 128 + dv0);
            const float g0 = silu(bf_lo(gr.x)), g1 = silu(bf_hi(gr.x)), g2 = silu(bf_lo(gr.y)), g3 = silu(bf_hi(gr.y));
            u32x2 pk; pk.x = pk2(g0 * acc[vt][0] * rstd * gw[0], g1 * acc[vt][1] * rstd * gw[1]); pk.y = pk2(g2 * acc[vt][2] * rstd * gw[2], g3 * acc[vt][3] * rstd * gw[3]);
            *(u32x2*)(cat + row * DM + h * 128 + dv0) = pk; }
    }
    { const float* lp = lbuf + (size_t)unit * 8192 + sdv * 64 + sdk;
#pragma unroll
      for (int k = 0; k < 4; ++k) { const f32x4 l = *(const f32x4*)(lp + 4 * k);
#pragma unroll
          for (int e = 0; e < 4; ++e) S[4 * k + e] = S[4 * k + e] * g128 + l[e]; } }
}

DI void sample_ret_unit(const Params& P, LAS unsigned char* lds, int bs, int tid, int lane, int w) {
    const bf16* proj = (const bf16*)(P.ws + WS_PROJ); const float* tabc = (const float*)(P.ws + WS_TABC); const float* tabs = (const float*)(P.ws + WS_TABS); bf16* cat = (bf16*)(P.ws + WS_CAT);
    LAS float* SEGR = (LAS float*)(lds);
    LAS float* RED = (LAS float*)(lds + 49152);
    LAS float* OBUF = (LAS float*)(lds + 65536);
    LAS float* SCR = (LAS float*)(lds + 81920);
    const int r0 = MP + 4 * bs;
    const float tc0 = tabc[4096 * 32 + (lane & 31)], tc1 = tabc[4097 * 32 + (lane & 31)], tc2 = tabc[4098 * 32 + (lane & 31)], tc3 = tabc[4099 * 32 + (lane & 31)];
    const float ts0 = tabs[4096 * 32 + (lane & 31)], ts1 = tabs[4097 * 32 + (lane & 31)], ts2 = tabs[4098 * 32 + (lane & 31)], ts3 = tabs[4099 * 32 + (lane & 31)];
    for (int ch = tid; ch < 1536; ch += 512) { const int i = ch / 384, c8 = (ch % 384) * 8; const u32x4 v = *(const u32x4*)(proj + (size_t)(r0 + i) * PW + c8); float f[8]; unpack8(v, f);
        LAS float* dst = SEGR + i * 3072 + c8;
        *(LAS f32x4*)dst = (f32x4){f[0], f[1], f[2], f[3]}; *(LAS f32x4*)(dst + 4) = (f32x4){f[4], f[5], f[6], f[7]}; }
    __syncthreads();
    for (int g = w; g < 64; g += 8) {
        const int i = (g & 31) >> 3; LAS float* p = SEGR + i * 3072 + (g >> 5) * 512 + (g & 7) * 64; const float scale = g < 32 ? 1.0f : 0.125f;
        const float x = p[lane];
        const float c = i == 0 ? tc0 : i == 1 ? tc1 : i == 2 ? tc2 : tc3, s = i == 0 ? ts0 : i == 1 ? ts1 : i == 2 ? ts2 : ts3;
        const float partner = __shfl_xor(x, 32);
        const float o = lane < 32 ? x * c - partner * s : x * c + partner * s;
        p[lane] = o * scale;
    }
    __syncthreads();
    if (tid < 128) { const int h = tid >> 4, i = (tid >> 2) & 3, j = tid & 3; float d = 0.f;
        if (j <= i) { const LAS float* q = SEGR + i * 3072 + h * 64; const LAS float* k = SEGR + j * 3072 + 512 + h * 64;
            for (int dd = 0; dd < 64; ++dd) d += q[dd] * k[dd];
            d *= ex2((float)(i - j) * sel_lg2(P, h)); }
        SCR[tid] = d; }
    __syncthreads();
    {
        const int dv = tid & 127, g = tid >> 7;
        float Sn[16];
        { const float* sp0 = P.state_ret + ((size_t)(bs * 8) * 64 + 16 * g) * 128 + dv;
#pragma unroll
          for (int r = 0; r < 16; ++r) Sn[r] = sp0[r * 128]; }
        for (int h = 0; h < 8; ++h) {
            const float lg = sel_lg2(P, h); const float g1 = ex2(lg), g2 = ex2(2.0f * lg), g3 = ex2(3.0f * lg), g4 = ex2(4.0f * lg);
            const size_t sidx = ((size_t)(bs * 8 + h) * 64 + 16 * g) * 128 + dv; float* so = P.out + OFF_RET_S + sidx;
            float S[16];
#pragma unroll
            for (int r = 0; r < 16; ++r) S[r] = Sn[r];
            if (h < 7) { const float* spn = P.state_ret + sidx + 8192;
#pragma unroll
                for (int r = 0; r < 16; ++r) Sn[r] = spn[r * 128]; }
            float part[4] = {0.f, 0.f, 0.f, 0.f};
#pragma unroll
            for (int r = 0; r < 16; ++r)
#pragma unroll
                for (int i = 0; i < 4; ++i) part[i] += SEGR[i * 3072 + h * 64 + 16 * g + r] * S[r];
#pragma unroll
            for (int i = 0; i < 4; ++i) RED[(((h & 1) * 4 + g) * 4 + i) * 128 + dv] = part[i];
            float v[4];
#pragma unroll
            for (int j = 0; j < 4; ++j) v[j] = SEGR[j * 3072 + 1024 + h * 128 + dv];
            const float v0 = v[0] * g3, v1 = v[1] * g2, v2 = v[2] * g1, v3 = v[3];
#pragma unroll
            for (int r = 0; r < 16; ++r) { const int kc = 512 + h * 64 + 16 * g + r;
                so[r * 128] = S[r] * g4 + SEGR[kc] * v0 + SEGR[3072 + kc] * v1 + SEGR[2 * 3072 + kc] * v2 + SEGR[3 * 3072 + kc] * v3; }
            __syncthreads();
            { const int i = g; float qs = 0.f;
#pragma unroll
              for (int gg = 0; gg < 4; ++gg) qs += RED[(((h & 1) * 4 + gg) * 4 + i) * 128 + dv];
              const float gi = (i == 0) ? g1 : (i == 1) ? g2 : (i == 2) ? g3 : g4;
              float o = gi * qs;
#pragma unroll
              for (int j = 0; j < 4; ++j) o += SCR[h * 16 + i * 4 + j] * v[j];
              OBUF[(h * 4 + i) * 128 + dv] = o; }
        }
    }
    __syncthreads();
    for (int rr = 4 * w; rr < 4 * w + 4; ++rr) { const int h = rr >> 2, i = rr & 3;
        const float x0 = OBUF[rr * 128 + lane], x1 = OBUF[rr * 128 + 64 + lane];
        const float mu = wave_sum(x0 + x1) * (1.0f / 128.0f); const float d0 = x0 - mu, d1 = x1 - mu;
        const float rstd = 1.0f / sqrtf(wave_sum(d0 * d0 + d1 * d1) * (1.0f / 128.0f) + 1e-6f);
        const float ga = SEGR[i * 3072 + 2048 + h * 128 + lane], gb = SEGR[i * 3072 + 2048 + h * 128 + 64 + lane];
        bf16* op = cat + (size_t)(r0 + i) * DM + h * 128;
        op[lane] = f2bf(silu(ga) * d0 * rstd * P.gn_w[h * 128 + lane]); op[64 + lane] = f2bf(silu(gb) * d1 * rstd * P.gn_w[h * 128 + 64 + lane]); }
    __syncthreads();
}
DI void sample_swa_unit(const Params& P, LAS unsigned char* lds, int bs, int tid, int lane, int w) {
    const bf16* proj = (const bf16*)(P.ws + WS_PROJ); const float* tabc = (const float*)(P.ws + WS_TABC); const float* tabs = (const float*)(P.ws + WS_TABS); bf16* cat = (bf16*)(P.ws + WS_CAT);
    LAS float* SEGS = (LAS float*)lds;
    LAS float* KF = (LAS float*)(lds + 20480);
    LAS float* VF = (LAS float*)(lds + 20480 + 34320);
    LAS float* PBUF = (LAS float*)(lds + 88592);
    const int r0 = MP + 4 * bs;
    const float tc0 = tabc[4096 * 32 + (lane & 31)], tc1 = tabc[4097 * 32 + (lane & 31)], tc2 = tabc[4098 * 32 + (lane & 31)], tc3 = tabc[4099 * 32 + (lane & 31)];
    const float ts0 = tabs[4096 * 32 + (lane & 31)], ts1 = tabs[4097 * 32 + (lane & 31)], ts2 = tabs[4098 * 32 + (lane & 31)], ts3 = tabs[4099 * 32 + (lane & 31)];
    for (int ch = tid; ch < 640; ch += 512) { const int i = ch / 160, c8 = (ch % 160) * 8; const u32x4 v = *(const u32x4*)(proj + (size_t)(r0 + i) * PW + 3072 + c8); float f[8]; unpack8(v, f);
        LAS float* dst = SEGS + i * 1280 + c8;
        *(LAS f32x4*)dst = (f32x4){f[0], f[1], f[2], f[3]}; *(LAS f32x4*)(dst + 4) = (f32x4){f[4], f[5], f[6], f[7]}; }
    {
        float* ok = P.out + OFF_SWAK_S + (size_t)bs * 16384; float* ov = P.out + OFF_SWAV_S + (size_t)bs * 16384;
        const float* ck = P.cache_k + (size_t)bs * 16384 + 512; const float* cv = P.cache_v + (size_t)bs * 16384 + 512;
        for (int e = tid * 4; e < 15872; e += 2048) { *(f32x4*)(ok + e) = *(const f32x4*)(ck + e); *(f32x4*)(ov + e) = *(const f32x4*)(cv + e); }
    }
    __syncthreads();
    for (int g = w; g < 72; g += 8) {
        LAS float* p; const float* normw; float scale; int i;
        if (g < 64) { i = g >> 4; p = SEGS + i * 1280 + (g & 15) * 64; normw = P.q_norm_w; scale = 0.125f * LOG2E; }
        else { const int gg = g - 64; i = gg >> 1; p = SEGS + i * 1280 + 1024 + (gg & 1) * 64; normw = P.k_norm_w; scale = 1.0f; }
        float x = p[lane];
        { const float ss = wave_sum(x * x); x = x * (1.0f / sqrtf(ss * (1.0f / 64.0f) + 1e-6f)) * normw[lane]; }
        const float c = i == 0 ? tc0 : i == 1 ? tc1 : i == 2 ? tc2 : tc3, s = i == 0 ? ts0 : i == 1 ? ts1 : i == 2 ? ts2 : ts3;
        const float partner = __shfl_xor(x, 32);
        const float o = lane < 32 ? x * c - partner * s : x * c + partner * s;
        p[lane] = o * scale;
    }
    __syncthreads();
    {
        float* ok = P.out + OFF_SWAK_S + (size_t)bs * 16384; float* ov = P.out + OFF_SWAV_S + (size_t)bs * 16384;
        const int i = tid >> 7, cc = tid & 127; ok[15872 + tid] = SEGS[i * 1280 + 1024 + cc]; ov[15872 + tid] = SEGS[i * 1280 + 1152 + cc];
    }
    for (int kvh = 0; kvh < 2; ++kvh) {
        for (int idx = tid; idx < 2048; idx += 512) { const int c = idx >> 4, d4 = (idx & 15) * 4; const size_t gi = ((size_t)(bs * 128 + c) * 2 + kvh) * 64 + d4;
            const f32x4 kv = *(const f32x4*)(P.cache_k + gi), vv = *(const f32x4*)(P.cache_v + gi);
            KF[c * 65 + d4] = kv[0]; KF[c * 65 + d4 + 1] = kv[1]; KF[c * 65 + d4 + 2] = kv[2]; KF[c * 65 + d4 + 3] = kv[3]; *(LAS f32x4*)(VF + c * 64 + d4) = vv; }
        if (tid < 256) { const int i = tid >> 6, d = tid & 63; KF[(128 + i) * 65 + d] = SEGS[i * 1280 + 1024 + kvh * 64 + d]; VF[(128 + i) * 64 + d] = SEGS[i * 1280 + 1152 + kvh * 64 + d]; }
        __syncthreads();
        { const int qv = tid >> 4, ks = tid & 15, i = qv >> 3, hh = kvh * 8 + (qv & 7); const LAS float* q = SEGS + i * 1280 + hh * 64; const float sink2 = P.sinks[hh] * LOG2E;
          float s[9];
#pragma unroll
          for (int kk = 0; kk < 9; ++kk) s[kk] = 0.f;
          const int klast = (ks + 128 < 132) ? ks + 128 : 131;
          for (int d = 0; d < 64; ++d) { const float qd = q[d];
#pragma unroll
              for (int kk = 0; kk < 8; ++kk) s[kk] += qd * KF[(ks + 16 * kk) * 65 + d];
              s[8] += qd * KF[klast * 65 + d]; }
          float mx = -INFINITY;
#pragma unroll
          for (int kk = 0; kk < 9; ++kk) { const int key = ks + 16 * kk; const bool valid = key < 132 && (key < 128 ? key >= i : (key - 128) <= i); s[kk] = valid ? s[kk] : -INFINITY; mx = fmaxf(mx, s[kk]); }
#pragma unroll
          for (int o = 1; o < 16; o <<= 1) mx = fmaxf(mx, __shfl_xor(mx, o));
          const float m = fmaxf(mx, sink2); float sum = 0.f;
#pragma unroll
          for (int kk = 0; kk < 9; ++kk) { s[kk] = ex2(s[kk] - m); sum += s[kk]; }
#pragma unroll
          for (int o = 1; o < 16; o <<= 1) sum += __shfl_xor(sum, o);
          const float inv = 1.0f / (sum + ex2(sink2 - m));
#pragma unroll
          for (int kk = 0; kk < 9; ++kk) { const int key = ks + 16 * kk; if (key < 132) PBUF[qv * 132 + key] = s[kk] * inv; } }
        __syncthreads();
        { const int qv = tid >> 4, ds = tid & 15, i = qv >> 3, hh = kvh * 8 + (qv & 7);
          float o0 = 0.f, o1 = 0.f, o2 = 0.f, o3 = 0.f;
          for (int key = 0; key < 132; ++key) { const float pr = PBUF[qv * 132 + key]; const LAS float* vr = VF + key * 64 + ds; o0 += pr * vr[0]; o1 += pr * vr[16]; o2 += pr * vr[32]; o3 += pr * vr[48]; }
          bf16* op = cat + (size_t)(r0 + i) * DM + 1024 + hh * 64 + ds; op[0] = f2bf(o0); op[16] = f2bf(o1); op[32] = f2bf(o2); op[48] = f2bf(o3); }
        __syncthreads();
    }
}

DI void act_fixup(const Params& P, int tid, int lane, int w) {
    bf16* ACT = (bf16*)(P.ws + WS_U); const float* GHF = (const float*)(P.ws + WS_GHF); const float* UHF = (const float*)(P.ws + WS_UHF); const float* GHL = (const float*)(P.ws + WS_GHL);
    for (int idx = blockIdx.x * 512 + tid; idx < 64 * 1408; idx += gridDim.x * 512) { const int pm = idx / 1408, f0 = (idx % 1408) * 4;
        f32x4 l0 = {0.f, 0.f, 0.f, 0.f}, l1 = {0.f, 0.f, 0.f, 0.f};
        if (pm & 15) { l0 = *(const f32x4*)(GHL + ((size_t)(pm - 1) * 2) * DFF + f0); l1 = *(const f32x4*)(GHL + ((size_t)(pm - 1) * 2 + 1) * DFF + f0); }
        const f32x4 g0 = *(const f32x4*)(GHF + ((size_t)pm * 2) * DFF + f0), g1 = *(const f32x4*)(GHF + ((size_t)pm * 2 + 1) * DFF + f0);
        const f32x4 u0 = *(const f32x4*)(UHF + ((size_t)pm * 2) * DFF + f0), u1 = *(const f32x4*)(UHF + ((size_t)pm * 2 + 1) * DFF + f0);
        const f32x4 w0 = *(const f32x4*)(P.conv_w + f0), w1 = *(const f32x4*)(P.conv_w + DFF + f0), w2 = *(const f32x4*)(P.conv_w + 2 * DFF + f0), cb = *(const f32x4*)(P.conv_b + f0);
        const f32x4 c0 = cb + w0 * l0 + w1 * l1 + w2 * g0, c1 = cb + w0 * l1 + w1 * g0 + w2 * g1;
        u32x2 a0, a1; a0.x = pk2(silu(c0[0]) * u0[0], silu(c0[1]) * u0[1]); a0.y = pk2(silu(c0[2]) * u0[2], silu(c0[3]) * u0[3]); a1.x = pk2(silu(c1[0]) * u1[0], silu(c1[1]) * u1[1]); a1.y = pk2(silu(c1[2]) * u1[2], silu(c1[3]) * u1[3]);
        *(u32x2*)(ACT + ((size_t)(f0 >> 6) * MT + 256 * pm) * 64 + (f0 & 63)) = a0; *(u32x2*)(ACT + ((size_t)(f0 >> 6) * MT + 256 * pm + 1) * 64 + (f0 & 63)) = a1;
        if ((pm & 15) == 15) { float* co = P.out + OFF_CONV_P + (size_t)(pm >> 4) * 2 * DFF + f0;
            *(f32x4*)co = *(const f32x4*)(GHL + ((size_t)pm * 2) * DFF + f0); *(f32x4*)(co + DFF) = *(const f32x4*)(GHL + ((size_t)pm * 2 + 1) * DFF + f0); }
    }
    const bf16* G = (const bf16*)(P.ws + WS_GSB); const bf16* U = (const bf16*)(P.ws + WS_USB);
    for (int it = blockIdx.x * 8 + w; it < 128 * 11; it += gridDim.x * 8) {
        const int bs = it / 11, wcn = it % 11; const int f0 = (wcn * 64 + lane) * 8;
        float cw0[8], cw1[8], cw2[8], cb[8], p1[8], p2[8];
        { const f32x4* a = (const f32x4*)(P.conv_w + f0); const f32x4* b = (const f32x4*)(P.conv_w + DFF + f0); const f32x4* c = (const f32x4*)(P.conv_w + 2 * DFF + f0); const f32x4* d = (const f32x4*)(P.conv_b + f0);
#pragma unroll
          for (int k = 0; k < 2; ++k) { const f32x4 av = a[k], bv = b[k], cv = c[k], dv = d[k];
#pragma unroll
              for (int e = 0; e < 4; ++e) { cw0[4 * k + e] = av[e]; cw1[4 * k + e] = bv[e]; cw2[4 * k + e] = cv[e]; cb[4 * k + e] = dv[e]; } } }
        { const float* st = P.state_conv + (size_t)bs * 2 * DFF + f0; const f32x4 a0 = *(const f32x4*)st, a1 = *(const f32x4*)(st + 4), b0 = *(const f32x4*)(st + DFF), b1 = *(const f32x4*)(st + DFF + 4);
#pragma unroll
          for (int e = 0; e < 4; ++e) { p2[e] = a0[e]; p2[4 + e] = a1[e]; p1[e] = b0[e]; p1[4 + e] = b1[e]; } }
        u32x4 gq[4], uq[4];
#pragma unroll
        for (int i = 0; i < 4; ++i) { gq[i] = *(const u32x4*)(G + (size_t)(4 * bs + i) * DFF + f0); uq[i] = *(const u32x4*)(U + (size_t)(4 * bs + i) * DFF + f0); }
#pragma unroll
        for (int i = 0; i < 4; ++i) {
            float g[8], u[8], a[8]; unpack8(gq[i], g); unpack8(uq[i], u);
#pragma unroll
            for (int e = 0; e < 8; ++e) { const float gc = cb[e] + cw0[e] * p2[e] + cw1[e] * p1[e] + cw2[e] * g[e]; a[e] = silu(gc) * u[e]; p2[e] = p1[e]; p1[e] = g[e]; }
            *(u32x4*)(ACT + ((size_t)(f0 >> 6) * MT + MP + 4 * bs + i) * 64 + (f0 & 63)) = pack8(a);
            if (i >= 2) { float* co = P.out + OFF_CONV_S + ((size_t)bs * 2 + (i - 2)) * DFF + f0; *(f32x4*)co = (f32x4){g[0], g[1], g[2], g[3]}; *(f32x4*)(co + 4) = (f32x4){g[4], g[5], g[6], g[7]}; }
        }
    }
}

#define XB_TMO      128
#define XB_XCNT(j)  (256  + 64 * (j))
#define XB_XSUB(j)  (1280 + 64 * (j))
#define XB_XGEN(j)  (2304 + 64 * (j))
#define XB_TOP      3328
#define XB_TOPGEN   3392
#define XCD_BAR_WORDS 3456
#define XB_SPIN_CAP (1u << 18)

__device__ __forceinline__ unsigned xb_ld(unsigned* p)              { return __hip_atomic_load(p, __ATOMIC_RELAXED, __HIP_MEMORY_SCOPE_AGENT); }
__device__ __forceinline__ unsigned xb_add(unsigned* p, unsigned v) { return __hip_atomic_fetch_add(p, v, __ATOMIC_RELAXED, __HIP_MEMORY_SCOPE_AGENT); }
__device__ __forceinline__ unsigned xb_xcc_id() { return (unsigned)__builtin_amdgcn_s_getreg((3 << 11) | 20) & 0xFu; }
#define XB_SPIN(cond, bar) do { unsigned _sp = 0; while (cond) { __builtin_amdgcn_s_sleep(1); \
    if ((++_sp & 255u) == 0u) { if (xb_ld(&(bar)[XB_TMO])) break; if (_sp > XB_SPIN_CAP) { atomicAdd(&(bar)[XB_TMO], 1u); break; } } } } while (0)

struct XcdBarrier {
    unsigned* bar; unsigned x;
    volatile LAS unsigned* st;
};

__device__ __forceinline__ XcdBarrier xcd_barrier_post(unsigned* bar, volatile LAS unsigned* st) {
    XcdBarrier b; b.bar = bar; b.x = xb_xcc_id(); b.st = st;
    if (threadIdx.x == 0) (void)xb_add(&bar[XB_XCNT(b.x)], 1u);
    return b;
}
__device__ __forceinline__ void xcd_barrier_complete(unsigned* bar, unsigned x, unsigned& nloc, unsigned& nx) {
    const unsigned G = gridDim.x * gridDim.y * gridDim.z;
    unsigned sum, cnt, mine, sp = 0u;
    for (;;) {
        sum = 0u; cnt = 0u; mine = 0u;
#pragma unroll
        for (unsigned j = 0; j < 16; ++j) { const unsigned c = xb_ld(&bar[XB_XCNT(j)]); sum += c; cnt += (c > 0u) ? 1u : 0u; mine = (j == x) ? c : mine; }
        if (sum == G) break;
        __builtin_amdgcn_s_sleep(1);
        if ((++sp & 255u) == 0u) { if (xb_ld(&bar[XB_TMO])) break; if (sp > XB_SPIN_CAP) { atomicAdd(&bar[XB_TMO], 1u); break; } }
    }
    nloc = mine > 0u ? mine : 1u; nx = cnt > 0u ? cnt : 1u;
}

__device__ __forceinline__ void xcd_barrier(const XcdBarrier& b) {
    asm volatile("s_waitcnt vmcnt(0)" ::: "memory");
    __syncthreads();
    if (threadIdx.x == 0) {
        unsigned* bar = b.bar;
        __builtin_amdgcn_s_waitcnt(0);
        unsigned nloc = b.st[0], nx = b.st[1];
        if (nloc == 0u) { xcd_barrier_complete(bar, b.x, nloc, nx); b.st[0] = nloc; b.st[1] = nx; }
        const unsigned old = xb_add(&bar[XB_XSUB(b.x)], 1u);
        const unsigned gen = old / nloc;
        if (old + 1u == (gen + 1u) * nloc) {
            __builtin_amdgcn_fence(__ATOMIC_RELEASE, "agent");
            asm volatile("s_waitcnt vmcnt(0)" ::: "memory");
            const unsigned og = xb_add(&bar[XB_TOP], 1u);
            const unsigned tg = og / nx;
            if (og + 1u == (tg + 1u) * nx) xb_add(&bar[XB_TOPGEN], 1u);
            else XB_SPIN(xb_ld(&bar[XB_TOPGEN]) == tg, bar);
            __builtin_amdgcn_fence(__ATOMIC_ACQUIRE, "agent");
            xb_add(&bar[XB_XGEN(b.x)], 1u);
            asm volatile("s_waitcnt vmcnt(0)" ::: "memory");
        } else {
            XB_SPIN(xb_ld(&bar[XB_XGEN(b.x)]) == gen, bar);
            __builtin_amdgcn_fence(__ATOMIC_ACQUIRE, "agent");
            asm volatile("s_waitcnt vmcnt(0)" ::: "memory");
        }
    }
    __syncthreads();
}

__global__ void __launch_bounds__(512, 2) fwd_kernel(Params P) {
    extern __shared__ __attribute__((aligned(16))) unsigned char lds_raw[];
    LAS unsigned char* lds = (LAS unsigned char*)lds_raw;
    const int tid = threadIdx.x, lane = tid & 63, w = __builtin_amdgcn_readfirstlane(tid >> 6);
    const int lo = P.ph_lo, hi = P.ph_hi;
#define IN(k) (lo <= (k) && (k) < hi)
#define SEAM(k) do { if (IN(k) && IN((k) + 1)) { xcd_barrier(bar); } } while (0)
    volatile LAS unsigned* bst = (volatile LAS unsigned*)(lds + LDS_BYTES - 16);
    if (tid < 2) bst[tid] = 0u;
    __syncthreads();
    XcdBarrier bar; bar.bar = (unsigned*)P.ws; bar.x = 0; bar.st = bst;
    if (hi - lo > 1) bar = xcd_barrier_post((unsigned*)P.ws, bst);
    if (hi > 1000) cg::this_grid().sync();
    if (IN(0)) { p0_prologue(P, lds, tid, lane, w); }
    SEAM(0);
    if (IN(1)) { pg8::Gemm g{(const bf16*)(P.ws + WS_HB), (const bf16*)(P.ws + WS_WIN), MT, PW, DM}; pg8::StaticOrder S; S.init(MT, PW, gridDim.x, (int)blockIdx.x, DM);
        pg8::EpiProj E{(bf16*)(P.ws + WS_PROJ), PW}; pg8::gemm_phase<pg8::EpiProj, pg8::StaticOrder, true, true>(lds, g, S, E);
        tail_transposes(P, lds, (MT / 256) * (PW / 256), 0, lane, w); }
    SEAM(1);
    if (IN(2)) {
        if (P.dummy == 0 || P.dummy == 1) for (int u = blockIdx.x; u < 256; u += gridDim.x) swa_prompt_unit(P, lds, u, tid, lane, w);
        if (P.dummy == 0 || P.dummy == 2) for (int u = blockIdx.x; u < 256; u += gridDim.x) { if (u < 128) sample_ret_unit(P, lds, u, tid, lane, w); else sample_swa_unit(P, lds, u - 128, tid, lane, w); }
        if (P.dummy == 1 || P.dummy == 2) {} else if (gridDim.x == 256) {
            const int c = blockIdx.x;
            if (c < 128) { for (int k = 0; k < 3; ++k) ret_l_unit(P, lds, c + 128 * k, tid, lane, w, k & 1); }
            else { for (int k = 0; k < 5; ++k) ret_l_unit(P, lds, 384 + (c - 128) + 128 * k, tid, lane, w, k & 1); }
        } else { int k = 0; for (int u = blockIdx.x; u < 1024; u += gridDim.x, ++k) ret_l_unit(P, lds, u, tid, lane, w, k & 1); }
        __syncthreads();
    }
    SEAM(2);
    if (IN(3)) { }
    if (IN(4)) {
        const float* lbuf = (const float*)(P.ws + WS_LBUF); const int sdv = tid >> 2, sdk = (tid & 3) * 16;
        for (int grp = blockIdx.x; grp < 256; grp += gridDim.x) {
            const int bh = grp >> 3, q = grp & 7; const float g128 = ex2(128.0f * sel_lg2(P, bh & 7));
            float S[16];
#pragma unroll
            for (int e = 0; e < 16; ++e) S[e] = 0.f;
            const float* lp = lbuf + (size_t)(bh * 32) * 8192 + sdv * 64 + sdk;
#pragma unroll 4
            for (int c = 0; c < 4 * q; ++c) { const f32x4 l0 = *(const f32x4*)(lp + (size_t)c * 8192), l1 = *(const f32x4*)(lp + (size_t)c * 8192 + 4), l2 = *(const f32x4*)(lp + (size_t)c * 8192 + 8), l3 = *(const f32x4*)(lp + (size_t)c * 8192 + 12);
#pragma unroll
                for (int e = 0; e < 4; ++e) { S[e] = S[e] * g128 + l0[e]; S[4 + e] = S[4 + e] * g128 + l1[e]; S[8 + e] = S[8 + e] * g128 + l2[e]; S[12 + e] = S[12 + e] * g128 + l3[e]; } }
#pragma unroll 1
            for (int k = 0; k < 4; ++k) ret_c_unit(P, lds, bh * 32 + 4 * q + k, tid, lane, w, k & 1, S, g128);
            if (q == 7) { int sdv2 = sdv, sdk2 = sdk; asm volatile("" : "+v"(sdv2), "+v"(sdk2));
                float* op = P.out + OFF_RET_P + ((size_t)bh * 64 + sdk2) * 128 + sdv2;
#pragma unroll
                for (int e = 0; e < 16; ++e) op[(size_t)e * 128] = S[e]; }
            __syncthreads();
        }
    }
    SEAM(4);
    if (IN(5)) { pg8::Gemm g{(const bf16*)(P.ws + WS_CAT), (const bf16*)(P.ws + WS_WO), MT, DM, DM}; pg8::TailSplitOrder<4> S; S.init(DM, gridDim.x, (int)blockIdx.x, DM, 4);
        pg8::EpiOut E{P.x_prompt, P.x_sample, P.out, (bf16*)(P.ws + WS_HB), (float*)(P.ws + WS_SSQ), (float*)(P.ws + WS_PART), DM / 64}; pg8::gemm_phase<pg8::EpiOut, pg8::TailSplitOrder<4>, true, true>(lds, g, S, E);
        tail_transposes(P, lds, 512 + 64, 1, lane, w); }
    SEAM(5);
    if (IN(6)) {
        const float* part = (const float*)(P.ws + WS_PART); bf16* hb = (bf16*)(P.ws + WS_HB); float* ssq = (float*)(P.ws + WS_SSQ);
        for (int rr = blockIdx.x * 8 + w; rr < 512; rr += gridDim.x * 8) {
            const float* xr = P.x_sample + (size_t)rr * DM; float* orow = P.out + (size_t)(MP + rr) * DM; float ss = 0.f;
#pragma unroll
            for (int j = 0; j < 8; ++j) { const int idx = 4 * lane + 256 * j; f32x4 v = *(const f32x4*)(xr + idx);
#pragma unroll
                for (int ks = 0; ks < 4; ++ks) v = v + *(const f32x4*)(part + (size_t)ks * (512 * 2048) + (size_t)rr * DM + idx);
                *(f32x4*)(orow + idx) = v; u32x2 pk; pk.x = pk2(v[0], v[1]); pk.y = pk2(v[2], v[3]); *(u32x2*)(hb + (size_t)(MP + rr) * DM + idx) = pk;
                ss += (v[0] * v[0] + v[1] * v[1]) + (v[2] * v[2] + v[3] * v[3]); }
            ss = wave_sum(ss); if (lane == 0) ssq[MP + rr] = ss;
        }
    }
    SEAM(6);
    if (IN(7)) { pg8::Gemm g{(const bf16*)(P.ws + WS_HB), (const bf16*)(P.ws + WS_WUP), MT, 2 * DFF, DM}; pg8::StaticOrder S; S.init(MT, 2 * DFF, gridDim.x, (int)blockIdx.x, DM);
        pg8::EpiUpAct E{(bf16*)(P.ws + WS_U), (bf16*)(P.ws + WS_GSB), (bf16*)(P.ws + WS_USB), (float*)(P.ws + WS_GHF), (float*)(P.ws + WS_UHF), (float*)(P.ws + WS_GHL), (const float*)(P.ws + WS_SSQ), P.conv_w, P.conv_b, (LAS float*)(lds + 131072)};
        pg8::gemm_phase<pg8::EpiUpAct, pg8::StaticOrder, true, true>(lds, g, S, E);
        tail_transposes(P, lds, (MT / 256) * (2 * DFF / 256), 2, lane, w); }
    SEAM(7);
    if (IN(8)) { act_fixup(P, tid, lane, w); }
    SEAM(8);
    if (IN(9)) { pg8::Gemm g{(const bf16*)(P.ws + WS_U), (const bf16*)(P.ws + WS_WDN), MT, DM, DFF, 1}; pg8::TailSplitOrder<KSPLIT> S; S.init(DM, gridDim.x, (int)blockIdx.x, DFF, 4);
        pg8::EpiDown E{P.dummy ? (float*)(P.ws + WS_G) : P.out, DFF / 64, (const bf16*)(P.ws + WS_HB), (float*)(P.ws + WS_PART)}; pg8::gemm_phase<pg8::EpiDown, pg8::TailSplitOrder<KSPLIT>, true, true>(lds, g, S, E); }
    SEAM(9);
    if (IN(10)) {
        const float* part = (const float*)(P.ws + WS_PART); float* o = P.out + (size_t)MP * DM;
        for (int idx = blockIdx.x * 512 + tid; idx < 512 * 2048 / 4; idx += gridDim.x * 512) { f32x4 v = *(const f32x4*)(o + 4 * (size_t)idx);
#pragma unroll
            for (int ks = 0; ks < KSPLIT; ++ks) v = v + *(const f32x4*)(part + (size_t)ks * (512 * 2048) + 4 * (size_t)idx);
            *(f32x4*)(o + 4 * (size_t)idx) = v; }
    }
#undef IN
#undef SEAM
}

extern "C" void kernel_launch(void* const* d_in, const int* in_sizes, int n_in, void* d_out, int out_size, void* d_ws, size_t ws_size, hipStream_t stream) {
    static int grid = 0;
    if (grid == 0) {
        if (n_in != 18 || in_sizes[0] != MP * DM || (size_t)out_size != OUT_TOTAL || ws_size < WS_END) {
            fprintf(stderr, "kernel_launch: unexpected shapes: n_in %d in0 %d out %d ws %zu (need %zu)\n", n_in, n_in > 0 ? in_sizes[0] : -1, out_size, ws_size, (size_t)WS_END); grid = -1; return; }
        int dev = 0, cus = 0, per_cu = 0;
        if (hipGetDevice(&dev) != hipSuccess || hipDeviceGetAttribute(&cus, hipDeviceAttributeMultiprocessorCount, dev) != hipSuccess) { grid = -1; return; }
        if (hipFuncSetAttribute((const void*)fwd_kernel, hipFuncAttributeMaxDynamicSharedMemorySize, LDS_BYTES) != hipSuccess) { fprintf(stderr, "kernel_launch: hipFuncSetAttribute failed\n"); grid = -1; return; }
        if (hipOccupancyMaxActiveBlocksPerMultiprocessor(&per_cu, (const void*)fwd_kernel, 512, LDS_BYTES) != hipSuccess || per_cu < 1) { fprintf(stderr, "kernel_launch: occupancy query says %d\n", per_cu); per_cu = 1; }
        (void)hipGetLastError();
        grid = cus * 1;
    }
    if (grid < 0) return;
    Params p{};
    p.x_prompt = (const float*)d_in[0]; p.x_sample = (const float*)d_in[1]; p.state_ret = (const float*)d_in[2]; p.cache_k = (const float*)d_in[3]; p.cache_v = (const float*)d_in[4];
    p.state_conv = (const float*)d_in[5]; p.attn_norm_w = (const float*)d_in[6]; p.w_in = (const float*)d_in[7]; p.q_norm_w = (const float*)d_in[8]; p.k_norm_w = (const float*)d_in[9];
    p.sinks = (const float*)d_in[10]; p.gn_w = (const float*)d_in[11]; p.w_o = (const float*)d_in[12]; p.ffn_norm_w = (const float*)d_in[13]; p.w_up = (const float*)d_in[14];
    p.conv_w = (const float*)d_in[15]; p.conv_b = (const float*)d_in[16]; p.w_down = (const float*)d_in[17];
    p.out = (float*)d_out; p.ws = (unsigned char*)d_ws;
    for (int i = 0; i < 32; ++i) p.inv_freq[i] = (float)pow(10000.0, -(double)i / 32.0);
    for (int h = 0; h < 8; ++h) p.lg2[h] = (float)log2(1.0 - exp2(-5.0 - (double)h));
#if MK_N_LAUNCHES == 1
    p.ph_lo = 0; p.ph_hi = NPH;
    if (hipMemsetAsync(d_ws, 0, 16384, stream) != hipSuccess) { fprintf(stderr, "kernel_launch: memset failed\n"); return; }
    void* args[] = {&p};
    hipError_t e = hipLaunchCooperativeKernel((const void*)fwd_kernel, dim3(grid), dim3(512), args, LDS_BYTES, stream);
    if (e != hipSuccess) fprintf(stderr, "kernel_launch: cooperative launch failed: %s (grid %d)\n", hipGetErrorString(e), grid);
#else
    {
        const int seq[] = PROBE_SEQ;
        for (unsigned k = 0; k < sizeof(seq) / sizeof(seq[0]); ++k) { p.ph_lo = seq[k] % 100; p.ph_hi = p.ph_lo + 1; p.dummy = seq[k] / 100; hipLaunchKernelGGL(fwd_kernel, dim3(grid), dim3(512), LDS_BYTES, stream, p); }
    }
#endif
}
```

```cpp
#include <hip/hip_runtime.h>
#include <hip/hip_cooperative_groups.h>
#include <cstdio>
#include <cstdint>
#include <cmath>
namespace cg = cooperative_groups;
namespace pg8 {
#define PG8_LAS __attribute__((address_space(3)))
typedef unsigned short bf16_t;
typedef short bf16x8 __attribute__((ext_vector_type(8)));
typedef float f32x4 __attribute__((ext_vector_type(4)));
typedef unsigned u32x4 __attribute__((ext_vector_type(4)));
constexpr int BM = 256, BK = 64, HALF = 128, HTB = HALF * BK * 2  , STAGE_BYTES = 8 * HTB, NXCD = 8, WGM = 8;

__host__ __device__ __forceinline__ int lds_byte(int r, int c) { const int st = (r >> 4) * 2 + (c >> 5), rr = r & 15, cc = c & 31, ob = rr * 64 + cc * 2; return st * 1024 + (ob ^ (((ob >> 9) & 1) << 5)); }
__host__ __device__ __forceinline__ void stage_rc(int b, int& R, int& C) { const int st = b / 1024, sb = b % 1024, swz = sb ^ (((sb >> 9) & 1) << 5); R = (st >> 1) * 16 + swz / 64; C = (st & 1) * 32 + (swz % 64) / 2; }
__host__ __device__ __forceinline__ int perm32(int rho) { const int n = rho >> 4, i = rho & 15; return 8 * (i >> 2) + 4 * n + (i & 3); }

struct Unit { int pm, pn, kt0, nt; };
struct Gemm { const bf16_t* A; const bf16_t* Bt; int M, N, K; int a_ktm; };

struct StaticOrder {
    int nM, nN, nwg, G, c, ntk, wgm;
    __host__ __device__ void init(int M, int N, int G_, int c_, int K_, int wgm_ = WGM) { nM = M / BM; nN = N / BM; nwg = nM * nN; G = G_; c = c_; ntk = K_ / BK; wgm = wgm_; }
    __host__ __device__ __forceinline__ bool next(int i, Unit& u) const {
        const long L = (long)i * G + c; if (L >= nwg) return false;
        int wgid = (int)L; { const int q = nwg / NXCD, r = nwg % NXCD, xcd = wgid % NXCD, off = wgid / NXCD; wgid = (xcd < r ? xcd * (q + 1) : r * (q + 1) + (xcd - r) * q) + off; }
        const int nig = wgm * nN, gid = wgid / nig, fm = gid * wgm, gsz = (nM - fm) < wgm ? (nM - fm) : wgm;
        u.pm = fm + ((wgid % nig) % gsz); u.pn = (wgid % nig) / gsz; u.kt0 = 0; u.nt = ntk; return true;
    }
    __device__ __forceinline__ void a_ready(const Unit&) const {}
    __device__ __forceinline__ void done(const Unit&) const {}
};

template <int KS> struct TailSplitOrder {
    StaticOrder so; int ntk;
    __host__ __device__ void init(int N, int G_, int c_, int K_, int wgm_) { so.init(16384, N, G_, c_, K_, wgm_); ntk = K_ / BK; }
    __host__ __device__ __forceinline__ bool next(int i, Unit& u) const {
        const long L = (long)i * so.G + so.c; Unit a; a.pm = 0; a.pn = 0; a.kt0 = 0; a.nt = ntk;
        const bool okA = so.next(i, a);
        const int s = (int)(L - so.nwg); const bool okB = (s >= 0) && (s < 2 * so.nN * KS);
        const int ks = s % KS, t = s / KS; const int ntb = ntk / KS;
        u.pm = okA ? a.pm : 64 + t / so.nN; u.pn = okA ? a.pn : t % so.nN; u.nt = okA ? a.nt : ntb; u.kt0 = okA ? 0 : ks * ntb;
        return okA || okB;
    }
    __device__ __forceinline__ void a_ready(const Unit&) const {}
    __device__ __forceinline__ void done(const Unit&) const {}
};

__device__ __forceinline__ unsigned cvt_pk_bf16(float lo, float hi) { unsigned r; asm volatile("v_cvt_pk_bf16_f32 %0, %1, %2" : "=v"(r) : "v"(lo), "v"(hi)); return r; }
constexpr int MROWS_PROMPT = 16384;
struct EpiProj {
    static constexpr bool PERM = true, AFTER_DRAIN = false;
    bf16_t* O; int ldc;
    __device__ __forceinline__ void operator()(const f32x4 (&acc)[2][2][4][2], const Unit& u, int wr, int wc, int fr, int fq) const {
        const int row0 = u.pm * BM + wr * 64 + fr; const int col0 = u.pn * BM + wc * 32 + 8 * fq;
#pragma unroll
        for (int ai = 0; ai < 2; ++ai)
#pragma unroll
            for (int m = 0; m < 4; ++m) { bf16_t* rowp = O + (size_t)(row0 + ai * HALF + m * 16) * ldc + col0;
#pragma unroll
                for (int bj = 0; bj < 2; ++bj) { const f32x4 v0 = acc[ai][bj][m][0], v1 = acc[ai][bj][m][1];
                    u32x4 w; w.x = cvt_pk_bf16(v0[0], v0[1]); w.y = cvt_pk_bf16(v0[2], v0[3]); w.z = cvt_pk_bf16(v1[0], v1[1]); w.w = cvt_pk_bf16(v1[2], v1[3]);
                    *(u32x4*)(rowp + bj * HALF) = w; } }
    }
};
struct EpiOut {
    static constexpr bool PERM = true, AFTER_DRAIN = false;
    const float* xp; const float* xs; float* out; bf16_t* hb; float* ssq; float* part; int ntk;
    __device__ __forceinline__ void operator()(const f32x4 (&acc)[2][2][4][2], const Unit& u, int wr, int wc, int fr, int fq) const {
        const int row0 = u.pm * BM + wr * 64 + fr; const int col0 = u.pn * BM + wc * 32 + 8 * fq;
        if (u.nt != ntk) {
            float* pp = part + (size_t)(u.kt0 / u.nt) * (512 * 2048);
#pragma unroll
            for (int ai = 0; ai < 2; ++ai)
#pragma unroll
                for (int m = 0; m < 4; ++m) { const size_t off = (size_t)(row0 + ai * HALF + m * 16 - MROWS_PROMPT) * 2048 + col0;
#pragma unroll
                    for (int bj = 0; bj < 2; ++bj) { *(f32x4*)(pp + off + bj * HALF) = acc[ai][bj][m][0]; *(f32x4*)(pp + off + bj * HALF + 4) = acc[ai][bj][m][1]; } }
            return;
        }
        const float* xb = xp;
#pragma unroll
        for (int ai = 0; ai < 2; ++ai) {
            f32x4 pre[4][2][2];
#pragma unroll
            for (int m = 0; m < 4; ++m) { const size_t off = (size_t)(row0 + ai * HALF + m * 16) * 2048 + col0;
#pragma unroll
                for (int bj = 0; bj < 2; ++bj) { pre[m][bj][0] = __builtin_nontemporal_load((const f32x4*)(xb + off + bj * HALF)); pre[m][bj][1] = __builtin_nontemporal_load((const f32x4*)(xb + off + bj * HALF + 4)); } }
#pragma unroll
            for (int m = 0; m < 4; ++m) { const int row = row0 + ai * HALF + m * 16; const size_t off = (size_t)row * 2048 + col0; float ss = 0.f;
#pragma unroll
                for (int bj = 0; bj < 2; ++bj) { const f32x4 h0 = pre[m][bj][0] + acc[ai][bj][m][0], h1 = pre[m][bj][1] + acc[ai][bj][m][1];
                    u32x4 w; w.x = cvt_pk_bf16(h0[0], h0[1]); w.y = cvt_pk_bf16(h0[2], h0[3]); w.z = cvt_pk_bf16(h1[0], h1[1]); w.w = cvt_pk_bf16(h1[2], h1[3]);
                    *(u32x4*)(hb + off + bj * HALF) = w;
                    ss += (h0[0] * h0[0] + h0[1] * h0[1]) + (h0[2] * h0[2] + h0[3] * h0[3]) + (h1[0] * h1[0] + h1[1] * h1[1]) + (h1[2] * h1[2] + h1[3] * h1[3]); }
                ss += __shfl_xor(ss, 16); ss += __shfl_xor(ss, 32);
                if (fq == 0) unsafeAtomicAdd(ssq + row, ss); }
        }
    }
};
struct EpiUpAct {
    static constexpr bool PERM = true, AFTER_DRAIN = false;
    bf16_t* ACT; bf16_t* GSB; bf16_t* USB; float* GHF; float* UHF; float* GHL; const float* ssq; const float* conv_w; const float* conv_b; PG8_LAS float* halo;
    __device__ __forceinline__ void operator()(f32x4 (&acc)[2][2][4][2], const Unit& u, int wr, int wc, int fr, int fq) const {
        const int row0 = u.pm * BM + wr * 64 + fr; const int f0 = u.pn * 128 + wc * 32 + 8 * fq;
        float cw0[8], cw1[8], cw2[8], cb[8];
#pragma unroll
        for (int k = 0; k < 2; ++k) { const f32x4 a = *(const f32x4*)(conv_w + f0 + 4 * k), b = *(const f32x4*)(conv_w + 5632 + f0 + 4 * k), c = *(const f32x4*)(conv_w + 2 * 5632 + f0 + 4 * k), d = *(const f32x4*)(conv_b + f0 + 4 * k);
#pragma unroll
            for (int e = 0; e < 4; ++e) { cw0[4 * k + e] = a[e]; cw1[4 * k + e] = b[e]; cw2[4 * k + e] = c[e]; cb[4 * k + e] = d[e]; } }
        float rsv[2][4];
#pragma unroll
        for (int ai = 0; ai < 2; ++ai)
#pragma unroll
            for (int m = 0; m < 4; ++m) rsv[ai][m] = ssq[row0 + ai * HALF + m * 16];
#pragma unroll
        for (int ai = 0; ai < 2; ++ai)
#pragma unroll
            for (int m = 0; m < 4; ++m) { const float rs = 1.0f / sqrtf(rsv[ai][m] * (1.0f / 2048.0f) + 1e-6f);
#pragma unroll
                for (int bj = 0; bj < 2; ++bj) { acc[ai][bj][m][0] = acc[ai][bj][m][0] * rs; acc[ai][bj][m][1] = acc[ai][bj][m][1] * rs; } }
        if (u.pm >= 64) {
#pragma unroll
            for (int ai = 0; ai < 2; ++ai)
#pragma unroll
                for (int m = 0; m < 4; ++m) { const size_t off = (size_t)(row0 + ai * HALF + m * 16 - MROWS_PROMPT) * 5632 + f0;
                    u32x4 w; w.x = cvt_pk_bf16(acc[ai][0][m][0][0], acc[ai][0][m][0][1]); w.y = cvt_pk_bf16(acc[ai][0][m][0][2], acc[ai][0][m][0][3]); w.z = cvt_pk_bf16(acc[ai][0][m][1][0], acc[ai][0][m][1][1]); w.w = cvt_pk_bf16(acc[ai][0][m][1][2], acc[ai][0][m][1][3]);
                    *(u32x4*)(GSB + off) = w;
                    w.x = cvt_pk_bf16(acc[ai][1][m][0][0], acc[ai][1][m][0][1]); w.y = cvt_pk_bf16(acc[ai][1][m][0][2], acc[ai][1][m][0][3]); w.z = cvt_pk_bf16(acc[ai][1][m][1][0], acc[ai][1][m][1][1]); w.w = cvt_pk_bf16(acc[ai][1][m][1][2], acc[ai][1][m][1][3]);
                    *(u32x4*)(USB + off) = w; }
            return;
        }
        if (fr >= 14) {
#pragma unroll
            for (int ai = 0; ai < 2; ++ai) { PG8_LAS float* hp = halo + ((ai * 2 + wr) * 2 + (fr - 14)) * 128 + wc * 32 + 8 * fq; *(PG8_LAS f32x4*)hp = acc[ai][0][3][0]; *(PG8_LAS f32x4*)(hp + 4) = acc[ai][0][3][1]; }
            if (wr == 1) { float* gp = GHL + ((size_t)u.pm * 2 + (fr - 14)) * 5632 + f0; *(f32x4*)gp = acc[1][0][3][0]; *(f32x4*)(gp + 4) = acc[1][0][3][1]; }
        }
        if (wr == 0 && fr < 2) { float* gp = GHF + ((size_t)u.pm * 2 + fr) * 5632 + f0; *(f32x4*)gp = acc[0][0][0][0]; *(f32x4*)(gp + 4) = acc[0][0][0][1];
            float* up = UHF + ((size_t)u.pm * 2 + fr) * 5632 + f0; *(f32x4*)up = acc[0][1][0][0]; *(f32x4*)(up + 4) = acc[0][1][0][1]; }
        asm volatile("s_waitcnt lgkmcnt(0)" ::: "memory"); __builtin_amdgcn_s_barrier(); asm volatile("" ::: "memory");
#pragma unroll
        for (int ai = 0; ai < 2; ++ai) {
            const int pb = ai * 2 + wr - 1;
            float prev[8];
            if (pb >= 0) { const PG8_LAS float* hp = halo + (pb * 2 + (fr & 1)) * 128 + wc * 32 + 8 * fq; const f32x4 a = *(const PG8_LAS f32x4*)hp, b = *(const PG8_LAS f32x4*)(hp + 4);
#pragma unroll
                for (int e = 0; e < 4; ++e) { prev[e] = a[e]; prev[4 + e] = b[e]; } }
            else {
#pragma unroll
                for (int k = 0; k < 8; ++k) prev[k] = 0.f; }
#pragma unroll
            for (int m = 0; m < 4; ++m) {
                float a[8];
#pragma unroll
                for (int kk = 0; kk < 4; ++kk) {
                    typedef float f32x2p __attribute__((ext_vector_type(2)));
                    const int k = 2 * kk;
                    const f32x2p g2 = {acc[ai][0][m][k >> 2][k & 3], acc[ai][0][m][k >> 2][(k & 3) + 1]}, u2 = {acc[ai][1][m][k >> 2][k & 3], acc[ai][1][m][k >> 2][(k & 3) + 1]};
                    f32x2p p1v, p2v;
#pragma unroll
                    for (int j = 0; j < 2; ++j) { const float g = g2[j];
                        const float t1 = fr == 15 ? prev[k + j] : g, t2 = fr >= 14 ? prev[k + j] : g;
                        int o1, o2; asm volatile("" : "=v"(o1), "=v"(o2));
                        p1v[j] = __int_as_float(__builtin_amdgcn_update_dpp(o1, __float_as_int(t1), 0x121, 0xf, 0xf, false));
                        p2v[j] = __int_as_float(__builtin_amdgcn_update_dpp(o2, __float_as_int(t2), 0x122, 0xf, 0xf, false));
                        prev[k + j] = g; }
                    const f32x2p c0 = {cw0[k], cw0[k + 1]}, c1 = {cw1[k], cw1[k + 1]}, c2 = {cw2[k], cw2[k + 1]}, cbv = {cb[k], cb[k + 1]};
                    const f32x2p gc = __builtin_elementwise_fma(c2, g2, __builtin_elementwise_fma(c1, p1v, __builtin_elementwise_fma(c0, p2v, cbv)));
                    const f32x2p ex = gc * -1.4426950408889634f; f32x2p den; den[0] = __builtin_amdgcn_exp2f(ex[0]); den[1] = __builtin_amdgcn_exp2f(ex[1]); den = den + 1.0f;
                    f32x2p rc; rc[0] = __builtin_amdgcn_rcpf(den[0]); rc[1] = __builtin_amdgcn_rcpf(den[1]);
                    const f32x2p av = (gc * u2) * rc; a[k] = av[0]; a[k + 1] = av[1]; }
                if (!(ai == 0 && wr == 0 && m == 0 && fr < 2)) { u32x4 w; w.x = cvt_pk_bf16(a[0], a[1]); w.y = cvt_pk_bf16(a[2], a[3]); w.z = cvt_pk_bf16(a[4], a[5]); w.w = cvt_pk_bf16(a[6], a[7]);
                    *(u32x4*)(ACT + ((size_t)(f0 >> 6) * 16896 + (row0 + ai * HALF + m * 16)) * 64 + (f0 & 63)) = w; }
            }
        }
    }
};
struct EpiDown {
    static constexpr bool PERM = true, AFTER_DRAIN = false;
    float* out; int ntk; const bf16_t* hb; float* part;
    __device__ __forceinline__ void operator()(const f32x4 (&acc)[2][2][4][2], const Unit& u, int wr, int wc, int fr, int fq) const {
        const int row0 = u.pm * BM + wr * 64 + fr; const int col0 = u.pn * BM + wc * 32 + 8 * fq;
        if (u.nt == ntk) {
#pragma unroll
        for (int ai = 0; ai < 2; ++ai) {
            u32x4 pre[4][2];
#pragma unroll
            for (int m = 0; m < 4; ++m) { const size_t off = (size_t)(row0 + ai * HALF + m * 16) * 2048 + col0;
#pragma unroll
                for (int bj = 0; bj < 2; ++bj) pre[m][bj] = __builtin_nontemporal_load((const u32x4*)(hb + off + bj * HALF)); }
#pragma unroll
            for (int m = 0; m < 4; ++m) { const size_t off = (size_t)(row0 + ai * HALF + m * 16) * 2048 + col0;
#pragma unroll
                for (int bj = 0; bj < 2; ++bj) { const u32x4 p = pre[m][bj];
                    const f32x4 h0 = {__uint_as_float(p.x << 16), __uint_as_float(p.x & 0xffff0000u), __uint_as_float(p.y << 16), __uint_as_float(p.y & 0xffff0000u)};
                    const f32x4 h1 = {__uint_as_float(p.z << 16), __uint_as_float(p.z & 0xffff0000u), __uint_as_float(p.w << 16), __uint_as_float(p.w & 0xffff0000u)};
                    *(f32x4*)(out + off + bj * HALF) = h0 + acc[ai][bj][m][0]; *(f32x4*)(out + off + bj * HALF + 4) = h1 + acc[ai][bj][m][1]; } }
        }
        } else {
            float* pp = part + (size_t)(u.kt0 / u.nt) * (512 * 2048);
#pragma unroll
        for (int ai = 0; ai < 2; ++ai)
#pragma unroll
            for (int m = 0; m < 4; ++m) { const size_t off = (size_t)(row0 + ai * HALF + m * 16 - MROWS_PROMPT) * 2048 + col0;
#pragma unroll
                for (int bj = 0; bj < 2; ++bj) { *(f32x4*)(pp + off + bj * HALF) = acc[ai][bj][m][0]; *(f32x4*)(pp + off + bj * HALF + 4) = acc[ai][bj][m][1]; } }
        }
    }
};
template <class Epi, class Sched, bool ALIGN_EPI = false, bool SP2 = false>
__device__ __forceinline__ void gemm_phase(PG8_LAS unsigned char* lds, const Gemm g, const Sched& S, const Epi& E) {
    const int tid = threadIdx.x, wid = __builtin_amdgcn_readfirstlane(tid >> 6), lane = tid & 63, wr = wid >> 2, wc = wid & 3, fr = lane & 15, fq = lane >> 4;
    const int K = g.K;
    unsigned voffA[2], voffB[2];
#pragma unroll
    for (int i = 0; i < 2; ++i) { int R, C; stage_rc(tid * 16 + i * 8192, R, C); const int Rb = Epi::PERM ? ((R & ~31) + perm32(R & 31)) : R;
        voffA[i] = (unsigned)(R * (g.a_ktm ? BK : K) + C) * 2u; voffB[i] = (unsigned)(Rb * K + C) * 2u; }
    const size_t kstep = (size_t)(BK * 2);
    const size_t hstep = (size_t)HALF * K * 2;
    const size_t tstep = 2 * hstep;
    const size_t kstepA = g.a_ktm ? (size_t)g.M * BK * 2 : kstep, hstepA = g.a_ktm ? (size_t)HALF * BK * 2 : hstep, tstepA = 2 * hstepA;
    const unsigned ldsw = (unsigned)wid * 1024u;
    const int aoff = lds_byte(wr * 64 + fr, fq * 8), boff = lds_byte(wc * 32 + fr, fq * 8);
#define PG8_SA(b, h) (((b) * 2 + (h)) * HTB)
#define PG8_SB(b, h) ((4 + (b) * 2 + (h)) * HTB)
#define PG8_STAGE(bufoff, gbase, voff) do { _Pragma("unroll") for (int _i = 0; _i < 2; ++_i) \
        __builtin_amdgcn_global_load_lds((const unsigned*)((const char*)(gbase) + (voff)[_i]), (PG8_LAS unsigned*)(lds + (bufoff) + ldsw + _i * 8192), 16, 0, 0); } while (0)
#define PG8_LDA(dst, b, h) do { _Pragma("unroll") for (int m = 0; m < 4; ++m) _Pragma("unroll") for (int k = 0; k < 2; ++k) dst[m][k] = *(const PG8_LAS bf16x8*)(lds + PG8_SA(b, h) + aoff + m * 2048 + k * 1024); } while (0)
#define PG8_LDB(dst, b, h) do { _Pragma("unroll") for (int n = 0; n < 2; ++n) _Pragma("unroll") for (int k = 0; k < 2; ++k) dst[n][k] = *(const PG8_LAS bf16x8*)(lds + PG8_SB(b, h) + boff + n * 2048 + k * 1024); } while (0)
#define PG8_MMA(ai, bj, At, Bt) do { __builtin_amdgcn_s_setprio(1); _Pragma("unroll") for (int m = 0; m < 4; ++m) _Pragma("unroll") for (int n = 0; n < 2; ++n) _Pragma("unroll") for (int k = 0; k < 2; ++k) \
        acc[ai][bj][m][n] = __builtin_amdgcn_mfma_f32_16x16x32_bf16(Bt[n][k], At[m][k], acc[ai][bj][m][n], 0, 0, 0); __builtin_amdgcn_s_setprio(0); } while (0)
#define PG8_WAIT_V(n) asm volatile("s_waitcnt vmcnt(" #n ")" ::: "memory")
#define PG8_WAIT_L(n) asm volatile("s_waitcnt lgkmcnt(" #n ")" ::: "memory")
#define PG8_BAR __builtin_amdgcn_s_barrier()
#define PG8_SCHED __builtin_amdgcn_sched_barrier(0)
    Unit cur, nxt; int ui = 0;
    if (!S.next(0, cur)) return;
    f32x4 acc[2][2][4][2];
#pragma unroll
    for (int a = 0; a < 2; ++a)
#pragma unroll
        for (int b = 0; b < 2; ++b)
#pragma unroll
            for (int m = 0; m < 4; ++m)
#pragma unroll
                for (int n = 0; n < 2; ++n) acc[a][b][m][n] = (f32x4){0.f, 0.f, 0.f, 0.f};
    bf16x8 At[4][2], B0[2][2], B1[2][2];
    const char* cA = (const char*)g.A + (size_t)cur.pm * tstepA + (size_t)cur.kt0 * kstepA; const char* cB = (const char*)g.Bt + (size_t)cur.pn * tstep + (size_t)cur.kt0 * kstep;
    S.a_ready(cur);
    if constexpr (SP2) {
        PG8_STAGE(PG8_SB(0, 0), cB, voffB); PG8_STAGE(PG8_SB(0, 1), cB + hstep, voffB); PG8_STAGE(PG8_SA(0, 0), cA, voffA); PG8_STAGE(PG8_SA(0, 1), cA + hstepA, voffA);
        if (wr == 1) PG8_BAR;
        PG8_WAIT_V(2); PG8_BAR;
        PG8_STAGE(PG8_SB(1, 0), cB + kstep, voffB); PG8_STAGE(PG8_SA(1, 0), cA + kstepA, voffA); PG8_STAGE(PG8_SB(1, 1), cB + hstep + kstep, voffB);
        PG8_WAIT_V(6); PG8_BAR;
    } else {
        PG8_STAGE(PG8_SB(0, 0), cB, voffB); PG8_STAGE(PG8_SA(0, 0), cA, voffA); PG8_STAGE(PG8_SB(0, 1), cB + hstep, voffB); PG8_STAGE(PG8_SA(0, 1), cA + hstepA, voffA);
        if (wr == 1) PG8_BAR;
        PG8_WAIT_V(4); PG8_BAR;
        PG8_STAGE(PG8_SB(1, 0), cB + kstep, voffB); PG8_STAGE(PG8_SA(1, 0), cA + kstepA, voffA); PG8_STAGE(PG8_SB(1, 1), cB + hstep + kstep, voffB);
        PG8_WAIT_V(6); PG8_BAR;
    }
    for (;;) {
        const bool has_next = S.next(ui + 1, nxt);
        const char* nA = has_next ? (const char*)g.A + (size_t)nxt.pm * tstepA + (size_t)nxt.kt0 * kstepA : cA; const char* nB = has_next ? (const char*)g.Bt + (size_t)nxt.pn * tstep + (size_t)nxt.kt0 * kstep : cB;
        const int nt = cur.nt;
        for (int t = 0; t < nt; t += 2) {
            const bool last = (t == nt - 2);
            const char* a1 = cA + (size_t)(t + 1) * kstepA;
            const char* a2 = last ? nA : cA + (size_t)(t + 2) * kstepA; const char* b2 = last ? nB : cB + (size_t)(t + 2) * kstep;
            const char* a3 = a2 + kstepA; const char* b3 = b2 + kstep;
            if (last && has_next) S.a_ready(nxt);
            if constexpr (SP2) {
            PG8_LDB(B0, 0, 0); PG8_LDB(B1, 0, 1); PG8_SCHED; PG8_LDA(At, 0, 0); PG8_STAGE(PG8_SA(1, 1), a1 + hstepA, voffA);
            PG8_WAIT_V(8); PG8_WAIT_L(0); PG8_BAR; PG8_MMA(0, 0, At, B0); PG8_MMA(0, 1, At, B1); PG8_BAR; PG8_SCHED;
            PG8_LDA(At, 0, 1); PG8_STAGE(PG8_SB(0, 0), b2, voffB); PG8_STAGE(PG8_SB(0, 1), b2 + hstep, voffB); PG8_STAGE(PG8_SA(0, 0), a2, voffA);
            PG8_WAIT_V(8); PG8_WAIT_L(0); PG8_BAR; PG8_MMA(1, 0, At, B0); PG8_MMA(1, 1, At, B1); PG8_BAR; PG8_SCHED;
            PG8_LDB(B0, 1, 0); PG8_LDB(B1, 1, 1); PG8_SCHED; PG8_LDA(At, 1, 0); PG8_STAGE(PG8_SA(0, 1), a2 + hstepA, voffA);
            PG8_WAIT_V(8); PG8_WAIT_L(0); PG8_BAR; PG8_MMA(0, 0, At, B0); PG8_MMA(0, 1, At, B1); PG8_BAR; PG8_SCHED;
            PG8_LDA(At, 1, 1); PG8_STAGE(PG8_SB(1, 0), b3, voffB); PG8_STAGE(PG8_SB(1, 1), b3 + hstep, voffB); PG8_STAGE(PG8_SA(1, 0), a3, voffA);
            PG8_WAIT_V(8); PG8_WAIT_L(0); PG8_BAR; PG8_MMA(1, 0, At, B0); PG8_MMA(1, 1, At, B1); PG8_BAR; PG8_SCHED;
            } else {
            PG8_LDB(B0, 0, 0); PG8_SCHED; PG8_LDA(At, 0, 0); PG8_STAGE(PG8_SA(1, 1), a1 + hstepA, voffA);
            PG8_WAIT_L(8); PG8_BAR; PG8_WAIT_L(0); PG8_MMA(0, 0, At, B0); PG8_BAR; PG8_SCHED;
            PG8_LDB(B1, 0, 1); PG8_STAGE(PG8_SB(0, 0), b2, voffB);
            PG8_BAR; PG8_WAIT_L(0); PG8_MMA(0, 1, At, B1); PG8_BAR;
            PG8_LDA(At, 0, 1); PG8_STAGE(PG8_SA(0, 0), a2, voffA);
            PG8_BAR; PG8_WAIT_L(0); PG8_MMA(1, 0, At, B0); PG8_BAR; PG8_SCHED;
            PG8_STAGE(PG8_SB(0, 1), b2 + hstep, voffB);
            PG8_WAIT_V(6); PG8_BAR; PG8_MMA(1, 1, At, B1); PG8_BAR;
            PG8_LDB(B0, 1, 0); PG8_SCHED; PG8_LDA(At, 1, 0); PG8_STAGE(PG8_SA(0, 1), a2 + hstepA, voffA);
            PG8_WAIT_L(8); PG8_BAR; PG8_WAIT_L(0); PG8_MMA(0, 0, At, B0); PG8_BAR; PG8_SCHED;
            PG8_LDB(B1, 1, 1); PG8_STAGE(PG8_SB(1, 0), b3, voffB);
            PG8_BAR; PG8_WAIT_L(0); PG8_MMA(0, 1, At, B1); PG8_BAR;
            PG8_LDA(At, 1, 1); PG8_STAGE(PG8_SA(1, 0), a3, voffA);
            PG8_BAR; PG8_WAIT_L(0); PG8_MMA(1, 0, At, B0); PG8_BAR; PG8_SCHED;
            PG8_STAGE(PG8_SB(1, 1), b3 + hstep, voffB);
            PG8_WAIT_V(6); PG8_BAR; PG8_MMA(1, 1, At, B1); PG8_BAR;
            }
        }
        if constexpr (ALIGN_EPI) { if (wr == 0) PG8_BAR; }
        if constexpr (!Epi::AFTER_DRAIN) { E(acc, cur, wr, wc, fr, fq); S.done(cur); }
        if (!has_next) break;
#pragma unroll
        for (int a = 0; a < 2; ++a)
#pragma unroll
            for (int b = 0; b < 2; ++b)
#pragma unroll
                for (int m = 0; m < 4; ++m)
#pragma unroll
                    for (int n = 0; n < 2; ++n) acc[a][b][m][n] = (f32x4){0.f, 0.f, 0.f, 0.f};
        cur = nxt; cA = nA; cB = nB; ++ui;
        if constexpr (ALIGN_EPI) { if (wr == 1) PG8_BAR; }
    }
    PG8_WAIT_V(0);
    if constexpr (!ALIGN_EPI) { if (wr == 0) PG8_BAR; }
    PG8_BAR;
    if constexpr (Epi::AFTER_DRAIN) { E.fused(acc, cur, wr, wc, fr, fq, lds, wid, lane); S.done(cur); }
#undef PG8_SA
#undef PG8_SB
#undef PG8_STAGE
#undef PG8_LDA
#undef PG8_LDB
#undef PG8_MMA
#undef PG8_WAIT_V
#undef PG8_WAIT_L
#undef PG8_BAR
#undef PG8_SCHED
}
}

#ifndef MK_N_LAUNCHES
#define MK_N_LAUNCHES 1
#endif
#ifndef PROBE_SEQ
#define PROBE_SEQ {0, 1, 2, 3, 4, 5, 6, 7, 8, 9, 10}
#endif
#define DI __device__ __forceinline__
#define LAS __attribute__((address_space(3)))
typedef unsigned short bf16;
typedef short bf16x8 __attribute__((ext_vector_type(8)));
typedef float f32x4 __attribute__((ext_vector_type(4)));
typedef float f32x2 __attribute__((ext_vector_type(2)));
typedef unsigned u32x4 __attribute__((ext_vector_type(4)));
typedef unsigned u32x2 __attribute__((ext_vector_type(2)));

constexpr int NPH = 11;
constexpr int MP = 16384, MS = 512, MT = 16896, DM = 2048, PW = 4352, DFF = 5632;
constexpr float LOG2E = 1.4426950408889634f;
constexpr size_t MiB = 1u << 20;
constexpr size_t WS_TABC = 1 * MiB, WS_TABS = 2 * MiB, WS_SSQ = 3 * MiB;
constexpr size_t WS_WUP = 4 * MiB, WS_WDN = 48 * MiB, WS_HB = 70 * MiB;
constexpr size_t WS_G = 136 * MiB, WS_U = WS_G + (size_t)MT * DFF * 2, WS_END = WS_U + (size_t)MT * DFF * 2;
constexpr size_t WS_WIN = 136 * MiB, WS_WO = 153 * MiB, WS_PROJ = 161 * MiB, WS_CAT = 302 * MiB, WS_LBUF = 368 * MiB, WS_SBUF = 400 * MiB;
static_assert(WS_PROJ + (size_t)MT * PW * 2 <= WS_CAT && WS_SBUF + 16 * MiB <= WS_END, "ws map");
constexpr size_t WS_PART = 161 * MiB;
constexpr int KSPLIT = 11;
constexpr size_t WS_GSB = 136 * MiB, WS_USB = 142 * MiB, WS_GHF = 148 * MiB, WS_UHF = 151 * MiB, WS_GHL = 154 * MiB;
constexpr size_t OFF_Y = 0, OFF_RET_P = (size_t)MT * DM, OFF_RET_S = OFF_RET_P + 262144, OFF_SWAK_P = OFF_RET_S + 8388608, OFF_SWAK_S = OFF_SWAK_P + 65536,
                 OFF_SWAV_P = OFF_SWAK_S + 2097152, OFF_SWAV_S = OFF_SWAV_P + 65536, OFF_CONV_P = OFF_SWAV_S + 2097152, OFF_CONV_S = OFF_CONV_P + 45056, OUT_TOTAL = OFF_CONV_S + 1441792;
constexpr int LDS_BYTES = 147456;

struct Params {
    const float *x_prompt, *x_sample, *state_ret, *cache_k, *cache_v, *state_conv, *attn_norm_w, *w_in, *q_norm_w, *k_norm_w, *sinks, *gn_w, *w_o, *ffn_norm_w, *w_up, *conv_w, *conv_b, *w_down;
    float* out; unsigned char* ws;
    float inv_freq[32]; float lg2[8];
    int ph_lo, ph_hi, dummy, pad;
};

DI float bf_lo(unsigned v) { return __uint_as_float(v << 16); }
DI float bf_hi(unsigned v) { return __uint_as_float(v & 0xffff0000u); }
DI unsigned pk2(float lo, float hi) { return pg8::cvt_pk_bf16(lo, hi); }
DI unsigned short f2bf(float f) { return (unsigned short)(pk2(f, f) & 0xffffu); }
DI void unpack8(const u32x4 v, float (&f)[8]) { f[0] = bf_lo(v.x); f[1] = bf_hi(v.x); f[2] = bf_lo(v.y); f[3] = bf_hi(v.y); f[4] = bf_lo(v.z); f[5] = bf_hi(v.z); f[6] = bf_lo(v.w); f[7] = bf_hi(v.w); }
DI u32x4 pack8(const float (&f)[8]) { u32x4 r; r.x = pk2(f[0], f[1]); r.y = pk2(f[2], f[3]); r.z = pk2(f[4], f[5]); r.w = pk2(f[6], f[7]); return r; }
DI bf16x8 as_bf16x8(u32x4 v) { return __builtin_bit_cast(bf16x8, v); }
DI float wave_sum(float v) {
#pragma unroll
    for (int o = 1; o < 64; o <<= 1) v += __shfl_xor(v, o);
    return v;
}
DI f32x4 mfma16(bf16x8 a, bf16x8 b, f32x4 c) { return __builtin_amdgcn_mfma_f32_16x16x32_bf16(a, b, c, 0, 0, 0); }
DI float ex2(float x) { return __builtin_amdgcn_exp2f(x); }
DI float silu(float x) { return x * __builtin_amdgcn_rcpf(1.0f + __expf(-x)); }
DI float sel_lg2(const Params& P, int h) { float r = P.lg2[0];
#pragma unroll
    for (int k = 1; k < 8; ++k) r = (h == k) ? P.lg2[k] : r;
    return r; }
#define LDS_WAIT() asm volatile("s_waitcnt lgkmcnt(0)" ::: "memory")

DI void p0_transpose_item(const float* W, int K, int N, bf16* WT, LAS float* scr, int item, int lane, const float* kscale, bool upmap) {
    const int nblk = N / 32, kb = item / nblk, nb = item % nblk, k0 = 64 * kb, n0 = 32 * nb;
    const int r0 = !upmap ? n0 : (n0 < DFF ? (n0 / 128) * 256 + (n0 % 128) : ((n0 - DFF) / 128) * 256 + 128 + ((n0 - DFF) % 128));
    f32x4 v[8];
#pragma unroll
    for (int i = 0; i < 8; ++i) { const int kk = 8 * i + (lane >> 3); v[i] = __builtin_nontemporal_load((const f32x4*)(W + (size_t)(k0 + kk) * N + n0 + 4 * (lane & 7))); }
#pragma unroll
    for (int i = 0; i < 8; ++i) { const int kk = 8 * i + (lane >> 3); f32x4 t = v[i]; if (kscale) t = t * kscale[k0 + kk]; LAS float* d = scr + kk * 33 + 4 * (lane & 7); d[0] = t[0]; d[1] = t[1]; d[2] = t[2]; d[3] = t[3]; }
    LDS_WAIT();
    const int c = lane & 7;
#pragma unroll
    for (int j = 0; j < 4; ++j) { const int n = (lane >> 3) + 8 * j; const LAS float* s = scr + (8 * c) * 33 + n;
        u32x4 o; o.x = pk2(s[0 * 33], s[1 * 33]); o.y = pk2(s[2 * 33], s[3 * 33]); o.z = pk2(s[4 * 33], s[5 * 33]); o.w = pk2(s[6 * 33], s[7 * 33]);
        *(u32x4*)(WT + (size_t)(r0 + n) * K + k0 + 8 * c) = o; }
    LDS_WAIT();
}
DI void rms_row_to_bf16(const float* xrow, const float* w, bf16* orow, int lane) {
    const f32x4* xr = (const f32x4*)xrow + lane; const f32x4* wr = (const f32x4*)w + lane;
    f32x4 v[8]; float s = 0.f;
#pragma unroll
    for (int j = 0; j < 8; ++j) { v[j] = xr[64 * j]; s += (v[j].x * v[j].x + v[j].y * v[j].y) + (v[j].z * v[j].z + v[j].w * v[j].w); }
    const float rstd = 1.0f / sqrtf(wave_sum(s) * (1.0f / 2048.0f) + 1e-6f);
#pragma unroll
    for (int j = 0; j < 8; ++j) { const f32x4 ww = wr[64 * j]; const f32x4 o = v[j] * rstd * ww; u32x2 pk; pk.x = pk2(o.x, o.y); pk.y = pk2(o.z, o.w); *(u32x2*)(orow + 4 * lane + 256 * j) = pk; }
}
DI void p0_prologue(const Params& P, LAS unsigned char* lds, int tid, int lane, int w) {
    LAS float* scr = (LAS float*)(lds + w * 16384);
    const int gw = blockIdx.x * 8 + w, NGW = gridDim.x * 8;
    bf16* wt_in = (bf16*)(P.ws + WS_WIN); bf16* wt_o = (bf16*)(P.ws + WS_WO);
    constexpr int I_IN = (DM / 64) * (PW / 32), I_O = (DM / 64) * (DM / 32);
    constexpr int NITEMS = I_IN + I_O;
    for (int it = gw; it < NITEMS; it += NGW) {
        if (it < I_IN) p0_transpose_item(P.w_in, DM, PW, wt_in, scr, it, lane, nullptr, false);
        else p0_transpose_item(P.w_o, DM, DM, wt_o, scr, it - I_IN, lane, nullptr, false);
    }
    bf16* a1 = (bf16*)(P.ws + WS_HB);
    for (int m = gw; m < MT; m += 2 * NGW) {
        const int m2 = m + NGW; const bool has2 = m2 < MT; const int mb = has2 ? m2 : m;
        const f32x4* xa = (const f32x4*)(m < MP ? P.x_prompt + (size_t)m * DM : P.x_sample + (size_t)(m - MP) * DM) + lane;
        const f32x4* xb = (const f32x4*)(mb < MP ? P.x_prompt + (size_t)mb * DM : P.x_sample + (size_t)(mb - MP) * DM) + lane;
        const f32x4* wr = (const f32x4*)P.attn_norm_w + lane;
        f32x4 va[8], vb[8]; float sa = 0.f, sb = 0.f;
#pragma unroll
        for (int j = 0; j < 8; ++j) { va[j] = __builtin_nontemporal_load(xa + 64 * j); vb[j] = __builtin_nontemporal_load(xb + 64 * j); }
#pragma unroll
        for (int j = 0; j < 8; ++j) { sa += (va[j].x * va[j].x + va[j].y * va[j].y) + (va[j].z * va[j].z + va[j].w * va[j].w); sb += (vb[j].x * vb[j].x + vb[j].y * vb[j].y) + (vb[j].z * vb[j].z + vb[j].w * vb[j].w); }
        const float ra = 1.0f / sqrtf(wave_sum(sa) * (1.0f / 2048.0f) + 1e-6f), rb = 1.0f / sqrtf(wave_sum(sb) * (1.0f / 2048.0f) + 1e-6f);
#pragma unroll
        for (int j = 0; j < 8; ++j) { const f32x4 ww = wr[64 * j]; const f32x4 oa = va[j] * ra * ww, ob = vb[j] * rb * ww; u32x2 pa, pb; pa.x = pk2(oa.x, oa.y); pa.y = pk2(oa.z, oa.w); pb.x = pk2(ob.x, ob.y); pb.y = pk2(ob.z, ob.w);
            *(u32x2*)(a1 + (size_t)m * DM + 4 * lane + 256 * j) = pa; if (has2) *(u32x2*)(a1 + (size_t)m2 * DM + 4 * lane + 256 * j) = pb; }
    }
    float* tabc = (float*)(P.ws + WS_TABC); float* tabs = (float*)(P.ws + WS_TABS); float* ssq = (float*)(P.ws + WS_SSQ);
    const int gt = blockIdx.x * 512 + tid, NGT = gridDim.x * 512;
    for (int idx = gt; idx < 4100 * 32; idx += NGT) { const int p = idx >> 5, i = idx & 31; const int pos = p < 4096 ? p : 16384 + (p - 4096);
        float inv = P.inv_freq[0];
#pragma unroll
        for (int k = 1; k < 32; ++k) inv = (i == k) ? P.inv_freq[k] : inv;
        const float ang = (float)pos * inv; const double rev = (double)ang * 0.15915494309189535; const float fr = (float)(rev - floor(rev));
        tabc[idx] = __builtin_amdgcn_cosf(fr); tabs[idx] = __builtin_amdgcn_sinf(fr); }
    for (int idx = gt; idx < MT; idx += NGT) ssq[idx] = 0.f;
}

struct RopeIn { u32x4 a, c; f32x4 c0, c1, s0, s1; };
DI RopeIn rope_load(const bf16* proj, const float* tabc, const float* tabs, size_t row, int tok, int col0, int qq) {
    RopeIn in; const bf16* p = proj + row * PW + col0 + 8 * qq; in.a = *(const u32x4*)p; in.c = *(const u32x4*)(p + 32);
    const float* tc = tabc + tok * 32 + 8 * qq; const float* ts = tabs + tok * 32 + 8 * qq;
    in.c0 = *(const f32x4*)tc; in.c1 = *(const f32x4*)(tc + 4); in.s0 = *(const f32x4*)ts; in.s1 = *(const f32x4*)(ts + 4); return in;
}
DI void rope_apply(const RopeIn& in, float scale, float (&o1)[8], float (&o2)[8]) {
    float x1[8], x2[8]; unpack8(in.a, x1); unpack8(in.c, x2);
#pragma unroll
    for (int e = 0; e < 8; ++e) { const float c = e < 4 ? in.c0[e & 3] : in.c1[e & 3], s = e < 4 ? in.s0[e & 3] : in.s1[e & 3]; o1[e] = (x1[e] * c - x2[e] * s) * scale; o2[e] = (x2[e] * c + x1[e] * s) * scale; }
}

DI void tail_transposes(const Params& P, LAS unsigned char* lds, int nunits, int slot, int lane, int w) {
    const int G = gridDim.x, rem = nunits % G; const int first = rem, nidle = G - rem;
    if ((int)blockIdx.x < first) return;
    LAS float* scr = (LAS float*)(lds + w * 16384);
    const int gw = ((int)blockIdx.x - first) * 8 + w, NGW = nidle * 8;
    bf16* wt_up = (bf16*)(P.ws + WS_WUP); bf16* wt_dn = (bf16*)(P.ws + WS_WDN);
    constexpr int I_UP = (DM / 64) * (2 * DFF / 32), I_DN = (DFF / 64) * (DM / 32), I_UP_A = 8000;
    if (slot == 0) { for (int it = gw; it < I_UP_A; it += NGW) p0_transpose_item(P.w_up, DM, 2 * DFF, wt_up, scr, it, lane, P.ffn_norm_w, true); }
    else if (slot == 1) { for (int it = gw; it < I_UP - I_UP_A; it += NGW) p0_transpose_item(P.w_up, DM, 2 * DFF, wt_up, scr, I_UP_A + it, lane, P.ffn_norm_w, true); }
    else { for (int it = gw; it < I_DN; it += NGW) p0_transpose_item(P.w_down, DFF, DM, wt_dn, scr, it, lane, nullptr, false); }
}

DI void swa_prompt_unit(const Params& P, LAS unsigned char* lds, int unit, int tid, int lane, int w) {
    const bf16* proj = (const bf16*)(P.ws + WS_PROJ); const float* tabc = (const float*)(P.ws + WS_TABC); const float* tabs = (const float*)(P.ws + WS_TABS); bf16* cat = (bf16*)(P.ws + WS_CAT);
    const int qb = unit & 31, kvh = (unit >> 5) & 1, b = unit >> 6;
    LAS unsigned char* KS = lds;
    LAS unsigned char* VT = lds + 36864;
    const int l15 = lane & 15, quad = lane >> 4; const int hh = kvh * 8 + w;
    {
        const int key = tid >> 1, half = tid & 1; const int tok = 128 * (qb - 1) + key;
        float o1a[8], o1b[8], o2a[8], o2b[8]; u32x4 vr[4];
        if (tok >= 0) {
            const size_t row = (size_t)b * 4096 + tok; const bf16* p = proj + row * PW + 4096 + kvh * 64 + 16 * half;
            const u32x4 a0 = *(const u32x4*)p, a1 = *(const u32x4*)(p + 8), b0 = *(const u32x4*)(p + 32), b1 = *(const u32x4*)(p + 40);
            float x1a[8], x1b[8], x2a[8], x2b[8]; unpack8(a0, x1a); unpack8(a1, x1b); unpack8(b0, x2a); unpack8(b1, x2b);
            float ss = 0.f;
#pragma unroll
            for (int e = 0; e < 8; ++e) ss += x1a[e] * x1a[e] + x1b[e] * x1b[e] + x2a[e] * x2a[e] + x2b[e] * x2b[e];
            ss += __shfl_xor(ss, 1);
            const float rstd = 1.0f / sqrtf(ss * (1.0f / 64.0f) + 1e-6f);
            float kw[48], tc[16], ts[16];
#pragma unroll
            for (int k4 = 0; k4 < 4; ++k4) { const f32x4 a = *(const f32x4*)(P.k_norm_w + 16 * half + 4 * k4), b2 = *(const f32x4*)(P.k_norm_w + 32 + 16 * half + 4 * k4), c4 = *(const f32x4*)(tabc + tok * 32 + 16 * half + 4 * k4), s4 = *(const f32x4*)(tabs + tok * 32 + 16 * half + 4 * k4);
#pragma unroll
                for (int e = 0; e < 4; ++e) { kw[4 * k4 + e] = a[e]; kw[32 + 4 * k4 + e] = b2[e]; tc[4 * k4 + e] = c4[e]; ts[4 * k4 + e] = s4[e]; } }
#pragma unroll
            for (int e = 0; e < 8; ++e) {
                { const float n1 = x1a[e] * rstd * kw[e], n2 = x2a[e] * rstd * kw[32 + e], c = tc[e], s = ts[e]; o1a[e] = n1 * c - n2 * s; o2a[e] = n2 * c + n1 * s; }
                { const float n1 = x1b[e] * rstd * kw[8 + e], n2 = x2b[e] * rstd * kw[40 + e], c = tc[8 + e], s = ts[8 + e]; o1b[e] = n1 * c - n2 * s; o2b[e] = n2 * c + n1 * s; } }
            const bf16* pv = proj + row * PW + 4224 + kvh * 64 + 32 * half;
#pragma unroll
            for (int k = 0; k < 4; ++k) vr[k] = *(const u32x4*)(pv + 8 * k);
            if (qb == 31 && key >= 128) {
                float* ok = P.out + OFF_SWAK_P + ((size_t)(b * 128 + key - 128) * 2 + kvh) * 64; float* ov = P.out + OFF_SWAV_P + ((size_t)(b * 128 + key - 128) * 2 + kvh) * 64;
#pragma unroll
                for (int e = 0; e < 8; ++e) { ok[16 * half + e] = o1a[e]; ok[16 * half + 8 + e] = o1b[e]; ok[32 + 16 * half + e] = o2a[e]; ok[32 + 16 * half + 8 + e] = o2b[e]; }
#pragma unroll
                for (int k = 0; k < 4; ++k) { float f[8]; unpack8(vr[k], f);
#pragma unroll
                    for (int e = 0; e < 8; ++e) ov[32 * half + 8 * k + e] = f[e]; }
            }
        } else {
#pragma unroll
            for (int e = 0; e < 8; ++e) { o1a[e] = 0.f; o1b[e] = 0.f; o2a[e] = 0.f; o2b[e] = 0.f; }
#pragma unroll
            for (int k = 0; k < 4; ++k) vr[k] = (u32x4){0u, 0u, 0u, 0u};
        }
        LAS unsigned char* kp = KS + key * 144 + half * 32;
        *(LAS u32x4*)(kp) = pack8(o1a); *(LAS u32x4*)(kp + 16) = pack8(o1b); *(LAS u32x4*)(kp + 64) = pack8(o2a); *(LAS u32x4*)(kp + 80) = pack8(o2b);
#pragma unroll
        for (int k = 0; k < 4; ++k) { const unsigned wv[4] = {vr[k].x, vr[k].y, vr[k].z, vr[k].w};
#pragma unroll
            for (int e = 0; e < 4; ++e) { const int d = 32 * half + 8 * k + 2 * e;
                *(LAS unsigned short*)(VT + d * 544 + key * 2) = (unsigned short)(wv[e] & 0xffffu); *(LAS unsigned short*)(VT + (d + 1) * 544 + key * 2) = (unsigned short)(wv[e] >> 16); } }
    }
    RopeIn qnext = rope_load(proj, tabc, tabs, (size_t)b * 4096 + 128 * qb + l15, 128 * qb + l15, 3072 + hh * 64, quad);
    float qw1[8], qw2[8];
    { const f32x4 a0 = *(const f32x4*)(P.q_norm_w + 8 * quad), a1 = *(const f32x4*)(P.q_norm_w + 8 * quad + 4), b0 = *(const f32x4*)(P.q_norm_w + 32 + 8 * quad), b1 = *(const f32x4*)(P.q_norm_w + 36 + 8 * quad);
#pragma unroll
      for (int e = 0; e < 4; ++e) { qw1[e] = a0[e]; qw1[4 + e] = a1[e]; qw2[e] = b0[e]; qw2[4 + e] = b1[e]; } }
    __syncthreads();
    {
        const float sink2 = P.sinks[hh] * LOG2E; const float qscale = 0.125f * LOG2E;
#pragma unroll 2
        for (int qt = 0; qt < 8; ++qt) {
            const int i = 16 * qt + l15; const int tok = 128 * qb + i; const size_t row = (size_t)b * 4096 + tok;
            const RopeIn qin = qnext;
            if (qt < 7) qnext = rope_load(proj, tabc, tabs, row + 16, tok + 16, 3072 + hh * 64, quad);
            float x1[8], x2[8], o1[8], o2[8]; unpack8(qin.a, x1); unpack8(qin.c, x2);
            float ss = 0.f;
#pragma unroll
            for (int e = 0; e < 8; ++e) ss += x1[e] * x1[e] + x2[e] * x2[e];
            ss += __shfl_xor(ss, 16); ss += __shfl_xor(ss, 32);
            const float rstd = qscale / sqrtf(ss * (1.0f / 64.0f) + 1e-6f);
#pragma unroll
            for (int e = 0; e < 8; ++e) { const float n1 = x1[e] * rstd * qw1[e], n2 = x2[e] * rstd * qw2[e], c = e < 4 ? qin.c0[e & 3] : qin.c1[e & 3], s = e < 4 ? qin.s0[e & 3] : qin.s1[e & 3]; o1[e] = n1 * c - n2 * s; o2[e] = n2 * c + n1 * s; }
            const bf16x8 qf0 = as_bf16x8(pack8(o1)), qf1 = as_bf16x8(pack8(o2));
            f32x4 acc[10];
#pragma unroll
            for (int tt = 0; tt < 9; ++tt) { int jt = qt + tt; jt = jt > 15 ? 15 : jt;
                const LAS unsigned char* kp = KS + (16 * jt + l15) * 144 + quad * 16;
                const bf16x8 k0 = *(const LAS bf16x8*)kp, k1 = *(const LAS bf16x8*)(kp + 64);
                f32x4 z = {0.f, 0.f, 0.f, 0.f}; z = mfma16(k0, qf0, z); acc[tt] = mfma16(k1, qf1, z); }
            acc[9] = (f32x4){0.f, 0.f, 0.f, 0.f};
            float mx = -INFINITY;
#pragma unroll
            for (int tt = 0; tt < 9; ++tt)
#pragma unroll
                for (int e = 0; e < 4; ++e) { const int kidx = 16 * (qt + tt) + 4 * quad + e; const bool valid = (kidx >= i) && (kidx <= i + 128) && (qb > 0 || kidx >= 128);
                    const float sv = valid ? acc[tt][e] : -INFINITY; acc[tt][e] = sv; mx = fmaxf(mx, sv); }
            mx = fmaxf(mx, __shfl_xor(mx, 16)); mx = fmaxf(mx, __shfl_xor(mx, 32));
            const float m = fmaxf(mx, sink2); float sum = 0.f;
#pragma unroll
            for (int tt = 0; tt < 9; ++tt)
#pragma unroll
                for (int e = 0; e < 4; ++e) { const float pe = ex2(acc[tt][e] - m); acc[tt][e] = pe; sum += pe; }
            sum += __shfl_xor(sum, 16); sum += __shfl_xor(sum, 32);
            const float inv = 1.0f / (sum + ex2(sink2 - m));
            f32x4 o[4];
#pragma unroll
            for (int dt = 0; dt < 4; ++dt) o[dt] = (f32x4){0.f, 0.f, 0.f, 0.f};
#pragma unroll
            for (int pp = 0; pp < 5; ++pp) {
                u32x4 pw; pw.x = pk2(acc[2 * pp][0], acc[2 * pp][1]); pw.y = pk2(acc[2 * pp][2], acc[2 * pp][3]); pw.z = pk2(acc[2 * pp + 1][0], acc[2 * pp + 1][1]); pw.w = pk2(acc[2 * pp + 1][2], acc[2 * pp + 1][3]);
                const bf16x8 pf = as_bf16x8(pw);
                int ja = qt + 2 * pp; ja = ja > 15 ? 15 : ja; int jb = qt + 2 * pp + 1; jb = jb > 15 ? 15 : jb;
#pragma unroll
                for (int dt = 0; dt < 4; ++dt) { const LAS unsigned char* vp = VT + (16 * dt + l15) * 544 + quad * 8;
                    const u32x2 va = *(const LAS u32x2*)(vp + ja * 32), vb = *(const LAS u32x2*)(vp + jb * 32);
                    const bf16x8 vf = as_bf16x8((u32x4){va.x, va.y, vb.x, vb.y}); o[dt] = mfma16(vf, pf, o[dt]); } }
#pragma unroll
            for (int dt = 0; dt < 4; ++dt) { bf16* op = cat + row * DM + 1024 + hh * 64 + 16 * dt + 4 * quad; u32x2 pk; pk.x = pk2(o[dt][0] * inv, o[dt][1] * inv); pk.y = pk2(o[dt][2] * inv, o[dt][3] * inv); *(u32x2*)op = pk; }
        }
    }
    __syncthreads();
}

DI void ret_stage_vt(const bf16* proj, LAS unsigned char* VT, size_t row0, int h, int tid) {
    const int j = tid >> 2, qq = tid & 3; const bf16* pv = proj + (row0 + j) * PW + 1024 + h * 128 + 32 * qq;
#pragma unroll
    for (int k = 0; k < 4; ++k) { const u32x4 v = *(const u32x4*)(pv + 8 * k); const unsigned wv[4] = {v.x, v.y, v.z, v.w};
#pragma unroll
        for (int e = 0; e < 4; ++e) { const int d = 32 * qq + 8 * k + 2 * e;
            *(LAS unsigned short*)(VT + d * 272 + j * 2) = (unsigned short)(wv[e] & 0xffffu); *(LAS unsigned short*)(VT + (d + 1) * 272 + j * 2) = (unsigned short)(wv[e] >> 16); } }
}
DI void ret_rope_k(const bf16* proj, const float* tabc, const float* tabs, size_t row, int tok, int col0, int qq, float scale, float (&o1)[8], float (&o2)[8]) {
    const RopeIn in = rope_load(proj, tabc, tabs, row, tok, col0, qq); rope_apply(in, scale, o1, o2);
}

DI void ret_l_unit(const Params& P, LAS unsigned char* lds0, int unit, int tid, int lane, int w, int buf) {
    LAS unsigned char* lds = lds0 + buf * 53248;
    const bf16* proj = (const bf16*)(P.ws + WS_PROJ); const float* tabc = (const float*)(P.ws + WS_TABC); const float* tabs = (const float*)(P.ws + WS_TABS); float* lbuf = (float*)(P.ws + WS_LBUF);
    const int c = unit & 31, h = (unit >> 5) & 7, b = unit >> 8; const float lg = sel_lg2(P, h);
    LAS unsigned char* KT = lds;
    LAS unsigned char* VT = lds + 17408;
    const size_t row0 = (size_t)b * 4096 + 128 * c;
    {
        const int j = tid >> 2, qq = tid & 3; float o1[8], o2[8];
        ret_rope_k(proj, tabc, tabs, row0 + j, 128 * c + j, 512 + h * 64, qq, 0.125f * ex2((float)(127 - j) * lg), o1, o2);
#pragma unroll
        for (int e = 0; e < 8; ++e) { *(LAS unsigned short*)(KT + (8 * qq + e) * 272 + j * 2) = f2bf(o1[e]); *(LAS unsigned short*)(KT + (32 + 8 * qq + e) * 272 + j * 2) = f2bf(o2[e]); }
        ret_stage_vt(proj, VT, row0, h, tid);
    }
    __syncthreads();
    {
        const int l15 = lane & 15, quad = lane >> 4;
        f32x4 acc[4];
#pragma unroll
        for (int kt = 0; kt < 4; ++kt) acc[kt] = (f32x4){0.f, 0.f, 0.f, 0.f};
#pragma unroll
        for (int s = 0; s < 4; ++s) { const bf16x8 vf = *(const LAS bf16x8*)(VT + (16 * w + l15) * 272 + (32 * s + 8 * quad) * 2);
#pragma unroll
            for (int kt = 0; kt < 4; ++kt) { const bf16x8 kf = *(const LAS bf16x8*)(KT + (16 * kt + l15) * 272 + (32 * s + 8 * quad) * 2); acc[kt] = mfma16(kf, vf, acc[kt]); } }
        float* lp = lbuf + (size_t)unit * 8192 + (16 * w + l15) * 64 + 4 * quad;
#pragma unroll
        for (int kt = 0; kt < 4; ++kt) *(f32x4*)(lp + 16 * kt) = acc[kt];
    }
}

DI void ret_scan(const Params& P, int tid) {
    const float* __restrict__ lbuf = (const float*)(P.ws + WS_LBUF); unsigned* __restrict__ sbuf = (unsigned*)(P.ws + WS_SBUF);
    for (int idx = blockIdx.x * 512 + tid; idx < 32 * 4096; idx += gridDim.x * 512) {
        const int bh = idx >> 12, e2 = idx & 4095; const float g128 = ex2(128.0f * sel_lg2(P, bh & 7));
        const size_t o0 = (size_t)(bh * 32) * 8192 + 2 * e2;
        f32x2 l[32];
#pragma unroll
        for (int c = 0; c < 32; ++c) l[c] = *(const f32x2*)(lbuf + o0 + (size_t)c * 8192);
        float s0 = 0.f, s1 = 0.f;
#pragma unroll
        for (int c = 0; c < 32; ++c) { sbuf[(o0 + (size_t)c * 8192) >> 1] = pk2(s0, s1); s0 = s0 * g128 + l[c].x; s1 = s1 * g128 + l[c].y; }
        const int dv = (2 * e2) >> 6, dk = (2 * e2) & 63; float* op = P.out + OFF_RET_P + ((size_t)bh * 64 + dk) * 128 + dv; op[0] = s0; op[128] = s1;
    }
}

DI void ret_c_unit(const Params& P, LAS unsigned char* lds0, int unit, int tid, int lane, int w, int buf, float (&S)[16], float g128) {
    LAS unsigned char* lds = lds0 + buf * 71680;
    LAS unsigned char* SL = lds + 53248;
    const bf16* proj = (const bf16*)(P.ws + WS_PROJ); const float* tabc = (const float*)(P.ws + WS_TABC); const float* tabs = (const float*)(P.ws + WS_TABS);
    const float* lbuf = (const float*)(P.ws + WS_LBUF); bf16* cat = (bf16*)(P.ws + WS_CAT);
    const int c = unit & 31, h = (unit >> 5) & 7, b = unit >> 8; const float lg = sel_lg2(P, h);
    LAS unsigned char* KS = lds;
    LAS unsigned char* VT = lds + 18432;
    const size_t row0 = (size_t)b * 4096 + 128 * c;
    const int l15 = lane & 15, quad = lane >> 4; const int il = 16 * w + l15; const size_t row = row0 + il;
    const RopeIn qin = rope_load(proj, tabc, tabs, row, 128 * c + il, h * 64, quad);
    const int sdv = tid >> 2, sdk = (tid & 3) * 16;
    {
        const int j = tid >> 2, qq = tid & 3; float o1[8], o2[8];
        ret_rope_k(proj, tabc, tabs, row0 + j, 128 * c + j, 512 + h * 64, qq, 0.125f, o1, o2);
        *(LAS u32x4*)(KS + j * 144 + qq * 16) = pack8(o1); *(LAS u32x4*)(KS + j * 144 + 64 + qq * 16) = pack8(o2);
        ret_stage_vt(proj, VT, row0, h, tid);
        { float s0[8], s1[8];
#pragma unroll
          for (int e = 0; e < 8; ++e) { s0[e] = S[e]; s1[e] = S[8 + e]; }
          *(LAS u32x4*)(SL + sdv * 144 + sdk * 2) = pack8(s0); *(LAS u32x4*)(SL + sdv * 144 + sdk * 2 + 16) = pack8(s1); }
    }
    __syncthreads();
    {
        float q1[8], q2[8]; rope_apply(qin, 1.0f, q1, q2);
        const bf16x8 qf0 = as_bf16x8(pack8(q1)), qf1 = as_bf16x8(pack8(q2));
        f32x4 acc[8];
#pragma unroll
        for (int vt = 0; vt < 8; ++vt) { const LAS unsigned char* sp = SL + (16 * vt + l15) * 144 + quad * 16; const bf16x8 s0 = *(const LAS bf16x8*)sp, s1 = *(const LAS bf16x8*)(sp + 64);
            f32x4 z = {0.f, 0.f, 0.f, 0.f}; z = mfma16(s0, qf0, z); acc[vt] = mfma16(s1, qf1, z); }
        const float rowdec = ex2((float)(il + 1) * lg);
#pragma unroll
        for (int vt = 0; vt < 8; ++vt) acc[vt] = acc[vt] * rowdec;
        f32x4 sc[8];
#pragma unroll
        for (int jt = 0; jt < 8; ++jt) {
            if (jt <= w) { const LAS unsigned char* kp = KS + (16 * jt + l15) * 144 + quad * 16; const bf16x8 k0 = *(const LAS bf16x8*)kp, k1 = *(const LAS bf16x8*)(kp + 64);
                f32x4 z = {0.f, 0.f, 0.f, 0.f}; z = mfma16(k0, qf0, z); z = mfma16(k1, qf1, z);
#pragma unroll
                for (int e = 0; e < 4; ++e) { const int diff = il - (16 * jt + 4 * quad + e); z[e] = diff >= 0 ? z[e] * ex2((float)diff * lg) : 0.f; }
                sc[jt] = z; }
            else sc[jt] = (f32x4){0.f, 0.f, 0.f, 0.f};
        }
#pragma unroll
        for (int pp = 0; pp < 4; ++pp) {
            if (2 * pp <= w) {
                u32x4 pw; pw.x = pk2(sc[2 * pp][0], sc[2 * pp][1]); pw.y = pk2(sc[2 * pp][2], sc[2 * pp][3]); pw.z = pk2(sc[2 * pp + 1][0], sc[2 * pp + 1][1]); pw.w = pk2(sc[2 * pp + 1][2], sc[2 * pp + 1][3]);
                const bf16x8 pf = as_bf16x8(pw);
#pragma unroll
                for (int vt = 0; vt < 8; ++vt) { const LAS unsigned char* vp = VT + (16 * vt + l15) * 272 + quad * 8;
                    const u32x2 va = *(const LAS u32x2*)(vp + (2 * pp) * 32), vb = *(const LAS u32x2*)(vp + (2 * pp + 1) * 32);
                    acc[vt] = mfma16(as_bf16x8((u32x4){va.x, va.y, vb.x, vb.y}), pf, acc[vt]); } }
        }
        float sum = 0.f;
#pragma unroll
        for (int vt = 0; vt < 8; ++vt) sum += (acc[vt][0] + acc[vt][1]) + (acc[vt][2] + acc[vt][3]);
        sum += __shfl_xor(sum, 16); sum += __shfl_xor(sum, 32);
        const float mu = sum * (1.0f / 128.0f); float var = 0.f;
#pragma unroll
        for (int vt = 0; vt < 8; ++vt) { acc[vt] = acc[vt] - mu; var += (acc[vt][0] * acc[vt][0] + acc[vt][1] * acc[vt][1]) + (acc[vt][2] * acc[vt][2] + acc[vt][3] * acc[vt][3]); }
        var += __shfl_xor(var, 16); var += __shfl_xor(var, 32);
        const float rstd = 1.0f / sqrtf(var * (1.0f / 128.0f) + 1e-6f);
#pragma unroll
        for (int vt = 0; vt < 8; ++vt) { const int dv0 = 16 * vt + 4 * quad; const u32x2 gr = *(const u32x2*)(proj + row * PW + 2048 + h * 128 + dv0); const f32x4 gw = *(const f32x4*)(P.gn_w + h * 128 + dv0);
            const float g0 = silu(bf_lo(gr.x)), g1 = silu(bf_hi(gr.x)), g2 = silu(bf_lo(gr.y)), g3 = silu(bf_hi(gr.y));
            u32x2 pk; pk.x = pk2(g0 * acc[vt][0] * rstd * gw[0], g1 * acc[vt][1] * rstd * gw[1]); pk.y = pk2(g2 * acc[vt][2] * rstd * gw[2], g3 * acc[vt][3] * rstd * gw[3]);
            *(u32x2*)(cat + row * DM + h * 128 + dv0) = pk; }
    }
    { const float* lp = lbuf + (size_t)unit * 8192 + sdv * 64 + sdk;
#pragma unroll
      for (int k = 0; k < 4; ++k) { const f32x4 l = *(const f32x4*)(lp + 4 * k);
#pragma unroll
          for (int e = 0; e < 4; ++e) S[4 * k + e] = S[4 * k + e] * g128 + l[e]; } }
}

DI void sample_ret_unit(const Params& P, LAS unsigned char* lds, int bs, int tid, int lane, int w) {
    const bf16* proj = (const bf16*)(P.ws + WS_PROJ); const float* tabc = (const float*)(P.ws + WS_TABC); const float* tabs = (const float*)(P.ws + WS_TABS); bf16* cat = (bf16*)(P.ws + WS_CAT);
    LAS float* SEGR = (LAS float*)(lds);
    LAS float* RED = (LAS float*)(lds + 49152);
    LAS float* OBUF = (LAS float*)(lds + 65536);
    LAS float* SCR = (LAS float*)(lds + 81920);
    const int r0 = MP + 4 * bs;
    const float tc0 = tabc[4096 * 32 + (lane & 31)], tc1 = tabc[4097 * 32 + (lane & 31)], tc2 = tabc[4098 * 32 + (lane & 31)], tc3 = tabc[4099 * 32 + (lane & 31)];
    const float ts0 = tabs[4096 * 32 + (lane & 31)], ts1 = tabs[4097 * 32 + (lane & 31)], ts2 = tabs[4098 * 32 + (lane & 31)], ts3 = tabs[4099 * 32 + (lane & 31)];
    for (int ch = tid; ch < 1536; ch += 512) { const int i = ch / 384, c8 = (ch % 384) * 8; const u32x4 v = *(const u32x4*)(proj + (size_t)(r0 + i) * PW + c8); float f[8]; unpack8(v, f);
        LAS float* dst = SEGR + i * 3072 + c8;
        *(LAS f32x4*)dst = (f32x4){f[0], f[1], f[2], f[3]}; *(LAS f32x4*)(dst + 4) = (f32x4){f[4], f[5], f[6], f[7]}; }
    __syncthreads();
    for (int g = w; g < 64; g += 8) {
        const int i = (g & 31) >> 3; LAS float* p = SEGR + i * 3072 + (g >> 5) * 512 + (g & 7) * 64; const float scale = g < 32 ? 1.0f : 0.125f;
        const float x = p[lane];
        const float c = i == 0 ? tc0 : i == 1 ? tc1 : i == 2 ? tc2 : tc3, s = i == 0 ? ts0 : i == 1 ? ts1 : i == 2 ? ts2 : ts3;
        const float partner = __shfl_xor(x, 32);
        const float o = lane < 32 ? x * c - partner * s : x * c + partner * s;
        p[lane] = o * scale;
    }
    __syncthreads();
    if (tid < 128) { const int h = tid >> 4, i = (tid >> 2) & 3, j = tid & 3; float d = 0.f;
        if (j <= i) { const LAS float* q = SEGR + i * 3072 + h * 64; const LAS float* k = SEGR + j * 3072 + 512 + h * 64;
            for (int dd = 0; dd < 64; ++dd) d += q[dd] * k[dd];
            d *= ex2((float)(i - j) * sel_lg2(P, h)); }
        SCR[tid] = d; }
    __syncthreads();
    {
        const int dv = tid & 127, g = tid >> 7;
        float Sn[16];
        { const float* sp0 = P.state_ret + ((size_t)(bs * 8) * 64 + 16 * g) * 128 + dv;
#pragma unroll
          for (int r = 0; r < 16; ++r) Sn[r] = sp0[r * 128]; }
        for (int h = 0; h < 8; ++h) {
            const float lg = sel_lg2(P, h); const float g1 = ex2(lg), g2 = ex2(2.0f * lg), g3 = ex2(3.0f * lg), g4 = ex2(4.0f * lg);
            const size_t sidx = ((size_t)(bs * 8 + h) * 64 + 16 * g) * 128 + dv; float* so = P.out + OFF_RET_S + sidx;
            float S[16];
#pragma unroll
            for (int r = 0; r < 16; ++r) S[r] = Sn[r];
            if (h < 7) { const float* spn = P.state_ret + sidx + 8192;
#pragma unroll
                for (int r = 0; r < 16; ++r) Sn[r] = spn[r * 128]; }
            float part[4] = {0.f, 0.f, 0.f, 0.f};
#pragma unroll
            for (int r = 0; r < 16; ++r)
#pragma unroll
                for (int i = 0; i < 4; ++i) part[i] += SEGR[i * 3072 + h * 64 + 16 * g + r] * S[r];
#pragma unroll
            for (int i = 0; i < 4; ++i) RED[(((h & 1) * 4 + g) * 4 + i) * 128 + dv] = part[i];
            float v[4];
#pragma unroll
            for (int j = 0; j < 4; ++j) v[j] = SEGR[j * 3072 + 1024 + h * 128 + dv];
            const float v0 = v[0] * g3, v1 = v[1] * g2, v2 = v[2] * g1, v3 = v[3];
#pragma unroll
            for (int r = 0; r < 16; ++r) { const int kc = 512 + h * 64 + 16 * g + r;
                so[r * 128] = S[r] * g4 + SEGR[kc] * v0 + SEGR[3072 + kc] * v1 + SEGR[2 * 3072 + kc] * v2 + SEGR[3 * 3072 + kc] * v3; }
            __syncthreads();
            { const int i = g; float qs = 0.f;
#pragma unroll
              for (int gg = 0; gg < 4; ++gg) qs += RED[(((h & 1) * 4 + gg) * 4 + i) * 128 + dv];
              const float gi = (i == 0) ? g1 : (i == 1) ? g2 : (i == 2) ? g3 : g4;
              float o = gi * qs;
#pragma unroll
              for (int j = 0; j < 4; ++j) o += SCR[h * 16 + i * 4 + j] * v[j];
              OBUF[(h * 4 + i) * 128 + dv] = o; }
        }
    }
    __syncthreads();
    for (int rr = 4 * w; rr < 4 * w + 4; ++rr) { const int h = rr >> 2, i = rr & 3;
        const float x0 = OBUF[rr * 128 + lane], x1 = OBUF[rr * 128 + 64 + lane];
        const float mu = wave_sum(x0 + x1) * (1.0f / 128.0f); const float d0 = x0 - mu, d1 = x1 - mu;
        const float rstd = 1.0f / sqrtf(wave_sum(d0 * d0 + d1 * d1) * (1.0f / 128.0f) + 1e-6f);
        const float ga = SEGR[i * 3072 + 2048 + h * 128 + lane], gb = SEGR[i * 3072 + 2048 + h * 128 + 64 + lane];
        bf16* op = cat + (size_t)(r0 + i) * DM + h * 128;
        op[lane] = f2bf(silu(ga) * d0 * rstd * P.gn_w[h * 128 + lane]); op[64 + lane] = f2bf(silu(gb) * d1 * rstd * P.gn_w[h * 128 + 64 + lane]); }
    __syncthreads();
}
DI void sample_swa_unit(const Params& P, LAS unsigned char* lds, int bs, int tid, int lane, int w) {
    const bf16* proj = (const bf16*)(P.ws + WS_PROJ); const float* tabc = (const float*)(P.ws + WS_TABC); const float* tabs = (const float*)(P.ws + WS_TABS); bf16* cat = (bf16*)(P.ws + WS_CAT);
    LAS float* SEGS = (LAS float*)lds;
    LAS float* KF = (LAS float*)(lds + 20480);
    LAS float* VF = (LAS float*)(lds + 20480 + 34320);
    LAS float* PBUF = (LAS float*)(lds + 88592);
    const int r0 = MP + 4 * bs;
    const float tc0 = tabc[4096 * 32 + (lane & 31)], tc1 = tabc[4097 * 32 + (lane & 31)], tc2 = tabc[4098 * 32 + (lane & 31)], tc3 = tabc[4099 * 32 + (lane & 31)];
    const float ts0 = tabs[4096 * 32 + (lane & 31)], ts1 = tabs[4097 * 32 + (lane & 31)], ts2 = tabs[4098 * 32 + (lane & 31)], ts3 = tabs[4099 * 32 + (lane & 31)];
    for (int ch = tid; ch < 640; ch += 512) { const int i = ch / 160, c8 = (ch % 160) * 8; const u32x4 v = *(const u32x4*)(proj + (size_t)(r0 + i) * PW + 3072 + c8); float f[8]; unpack8(v, f);
        LAS float* dst = SEGS + i * 1280 + c8;
        *(LAS f32x4*)dst = (f32x4){f[0], f[1], f[2], f[3]}; *(LAS f32x4*)(dst + 4) = (f32x4){f[4], f[5], f[6], f[7]}; }
    {
        float* ok = P.out + OFF_SWAK_S + (size_t)bs * 16384; float* ov = P.out + OFF_SWAV_S + (size_t)bs * 16384;
        const float* ck = P.cache_k + (size_t)bs * 16384 + 512; const float* cv = P.cache_v + (size_t)bs * 16384 + 512;
        for (int e = tid * 4; e < 15872; e += 2048) { *(f32x4*)(ok + e) = *(const f32x4*)(ck + e); *(f32x4*)(ov + e) = *(const f32x4*)(cv + e); }
    }
    __syncthreads();
    for (int g = w; g < 72; g += 8) {
        LAS float* p; const float* normw; float scale; int i;
        if (g < 64) { i = g >> 4; p = SEGS + i * 1280 + (g & 15) * 64; normw = P.q_norm_w; scale = 0.125f * LOG2E; }
        else { const int gg = g - 64; i = gg >> 1; p = SEGS + i * 1280 + 1024 + (gg & 1) * 64; normw = P.k_norm_w; scale = 1.0f; }
        float x = p[lane];
        { const float ss = wave_sum(x * x); x = x * (1.0f / sqrtf(ss * (1.0f / 64.0f) + 1e-6f)) * normw[lane]; }
        const float c = i == 0 ? tc0 : i == 1 ? tc1 : i == 2 ? tc2 : tc3, s = i == 0 ? ts0 : i == 1 ? ts1 : i == 2 ? ts2 : ts3;
        const float partner = __shfl_xor(x, 32);
        const float o = lane < 32 ? x * c - partner * s : x * c + partner * s;
        p[lane] = o * scale;
    }
    __syncthreads();
    {
        float* ok = P.out + OFF_SWAK_S + (size_t)bs * 16384; float* ov = P.out + OFF_SWAV_S + (size_t)bs * 16384;
        const int i = tid >> 7, cc = tid & 127; ok[15872 + tid] = SEGS[i * 1280 + 1024 + cc]; ov[15872 + tid] = SEGS[i * 1280 + 1152 + cc];
    }
    for (int kvh = 0; kvh < 2; ++kvh) {
        for (int idx = tid; idx < 2048; idx += 512) { const int c = idx >> 4, d4 = (idx & 15) * 4; const size_t gi = ((size_t)(bs * 128 + c) * 2 + kvh) * 64 + d4;
            const f32x4 kv = *(const f32x4*)(P.cache_k + gi), vv = *(const f32x4*)(P.cache_v + gi);
            KF[c * 65 + d4] = kv[0]; KF[c * 65 + d4 + 1] = kv[1]; KF[c * 65 + d4 + 2] = kv[2]; KF[c * 65 + d4 + 3] = kv[3]; *(LAS f32x4*)(VF + c * 64 + d4) = vv; }
        if (tid < 256) { const int i = tid >> 6, d = tid & 63; KF[(128 + i) * 65 + d] = SEGS[i * 1280 + 1024 + kvh * 64 + d]; VF[(128 + i) * 64 + d] = SEGS[i * 1280 + 1152 + kvh * 64 + d]; }
        __syncthreads();
        { const int qv = tid >> 4, ks = tid & 15, i = qv >> 3, hh = kvh * 8 + (qv & 7); const LAS float* q = SEGS + i * 1280 + hh * 64; const float sink2 = P.sinks[hh] * LOG2E;
          float s[9];
#pragma unroll
          for (int kk = 0; kk < 9; ++kk) s[kk] = 0.f;
          const int klast = (ks + 128 < 132) ? ks + 128 : 131;
          for (int d = 0; d < 64; ++d) { const float qd = q[d];
#pragma unroll
              for (int kk = 0; kk < 8; ++kk) s[kk] += qd * KF[(ks + 16 * kk) * 65 + d];
              s[8] += qd * KF[klast * 65 + d]; }
          float mx = -INFINITY;
#pragma unroll
          for (int kk = 0; kk < 9; ++kk) { const int key = ks + 16 * kk; const bool valid = key < 132 && (key < 128 ? key >= i : (key - 128) <= i); s[kk] = valid ? s[kk] : -INFINITY; mx = fmaxf(mx, s[kk]); }
#pragma unroll
          for (int o = 1; o < 16; o <<= 1) mx = fmaxf(mx, __shfl_xor(mx, o));
          const float m = fmaxf(mx, sink2); float sum = 0.f;
#pragma unroll
          for (int kk = 0; kk < 9; ++kk) { s[kk] = ex2(s[kk] - m); sum += s[kk]; }
#pragma unroll
          for (int o = 1; o < 16; o <<= 1) sum += __shfl_xor(sum, o);
          const float inv = 1.0f / (sum + ex2(sink2 - m));
#pragma unroll
          for (int kk = 0; kk < 9; ++kk) { const int key = ks + 16 * kk; if (key < 132) PBUF[qv * 132 + key] = s[kk] * inv; } }
        __syncthreads();
        { const int qv = tid >> 4, ds = tid & 15, i = qv >> 3, hh = kvh * 8 + (qv & 7);
          float o0 = 0.f, o1 = 0.f, o2 = 0.f, o3 = 0.f;
          for (int key = 0; key < 132; ++key) { const float pr = PBUF[qv * 132 + key]; const LAS float* vr = VF + key * 64 + ds; o0 += pr * vr[0]; o1 += pr * vr[16]; o2 += pr * vr[32]; o3 += pr * vr[48]; }
          bf16* op = cat + (size_t)(r0 + i) * DM + 1024 + hh * 64 + ds; op[0] = f2bf(o0); op[16] = f2bf(o1); op[32] = f2bf(o2); op[48] = f2bf(o3); }
        __syncthreads();
    }
}

DI void act_fixup(const Params& P, int tid, int lane, int w) {
    bf16* ACT = (bf16*)(P.ws + WS_U); const float* GHF = (const float*)(P.ws + WS_GHF); const float* UHF = (const float*)(P.ws + WS_UHF); const float* GHL = (const float*)(P.ws + WS_GHL);
    for (int idx = blockIdx.x * 512 + tid; idx < 64 * 1408; idx += gridDim.x * 512) { const int pm = idx / 1408, f0 = (idx % 1408) * 4;
        f32x4 l0 = {0.f, 0.f, 0.f, 0.f}, l1 = {0.f, 0.f, 0.f, 0.f};
        if (pm & 15) { l0 = *(const f32x4*)(GHL + ((size_t)(pm - 1) * 2) * DFF + f0); l1 = *(const f32x4*)(GHL + ((size_t)(pm - 1) * 2 + 1) * DFF + f0); }
        const f32x4 g0 = *(const f32x4*)(GHF + ((size_t)pm * 2) * DFF + f0), g1 = *(const f32x4*)(GHF + ((size_t)pm * 2 + 1) * DFF + f0);
        const f32x4 u0 = *(const f32x4*)(UHF + ((size_t)pm * 2) * DFF + f0), u1 = *(const f32x4*)(UHF + ((size_t)pm * 2 + 1) * DFF + f0);
        const f32x4 w0 = *(const f32x4*)(P.conv_w + f0), w1 = *(const f32x4*)(P.conv_w + DFF + f0), w2 = *(const f32x4*)(P.conv_w + 2 * DFF + f0), cb = *(const f32x4*)(P.conv_b + f0);
        const f32x4 c0 = cb + w0 * l0 + w1 * l1 + w2 * g0, c1 = cb + w0 * l1 + w1 * g0 + w2 * g1;
        u32x2 a0, a1; a0.x = pk2(silu(c0[0]) * u0[0], silu(c0[1]) * u0[1]); a0.y = pk2(silu(c0[2]) * u0[2], silu(c0[3]) * u0[3]); a1.x = pk2(silu(c1[0]) * u1[0], silu(c1[1]) * u1[1]); a1.y = pk2(silu(c1[2]) * u1[2], silu(c1[3]) * u1[3]);
        *(u32x2*)(ACT + ((size_t)(f0 >> 6) * MT + 256 * pm) * 64 + (f0 & 63)) = a0; *(u32x2*)(ACT + ((size_t)(f0 >> 6) * MT + 256 * pm + 1) * 64 + (f0 & 63)) = a1;
        if ((pm & 15) == 15) { float* co = P.out + OFF_CONV_P + (size_t)(pm >> 4) * 2 * DFF + f0;
            *(f32x4*)co = *(const f32x4*)(GHL + ((size_t)pm * 2) * DFF + f0); *(f32x4*)(co + DFF) = *(const f32x4*)(GHL + ((size_t)pm * 2 + 1) * DFF + f0); }
    }
    const bf16* G = (const bf16*)(P.ws + WS_GSB); const bf16* U = (const bf16*)(P.ws + WS_USB);
    for (int it = blockIdx.x * 8 + w; it < 128 * 11; it += gridDim.x * 8) {
        const int bs = it / 11, wcn = it % 11; const int f0 = (wcn * 64 + lane) * 8;
        float cw0[8], cw1[8], cw2[8], cb[8], p1[8], p2[8];
        { const f32x4* a = (const f32x4*)(P.conv_w + f0); const f32x4* b = (const f32x4*)(P.conv_w + DFF + f0); const f32x4* c = (const f32x4*)(P.conv_w + 2 * DFF + f0); const f32x4* d = (const f32x4*)(P.conv_b + f0);
#pragma unroll
          for (int k = 0; k < 2; ++k) { const f32x4 av = a[k], bv = b[k], cv = c[k], dv = d[k];
#pragma unroll
              for (int e = 0; e < 4; ++e) { cw0[4 * k + e] = av[e]; cw1[4 * k + e] = bv[e]; cw2[4 * k + e] = cv[e]; cb[4 * k + e] = dv[e]; } } }
        { const float* st = P.state_conv + (size_t)bs * 2 * DFF + f0; const f32x4 a0 = *(const f32x4*)st, a1 = *(const f32x4*)(st + 4), b0 = *(const f32x4*)(st + DFF), b1 = *(const f32x4*)(st + DFF + 4);
#pragma unroll
          for (int e = 0; e < 4; ++e) { p2[e] = a0[e]; p2[4 + e] = a1[e]; p1[e] = b0[e]; p1[4 + e] = b1[e]; } }
        u32x4 gq[4], uq[4];
#pragma unroll
        for (int i = 0; i < 4; ++i) { gq[i] = *(const u32x4*)(G + (size_t)(4 * bs + i) * DFF + f0); uq[i] = *(const u32x4*)(U + (size_t)(4 * bs + i) * DFF + f0); }
#pragma unroll
        for (int i = 0; i < 4; ++i) {
            float g[8], u[8], a[8]; unpack8(gq[i], g); unpack8(uq[i], u);
#pragma unroll
            for (int e = 0; e < 8; ++e) { const float gc = cb[e] + cw0[e] * p2[e] + cw1[e] * p1[e] + cw2[e] * g[e]; a[e] = silu(gc) * u[e]; p2[e] = p1[e]; p1[e] = g[e]; }
            *(u32x4*)(ACT + ((size_t)(f0 >> 6) * MT + MP + 4 * bs + i) * 64 + (f0 & 63)) = pack8(a);
            if (i >= 2) { float* co = P.out + OFF_CONV_S + ((size_t)bs * 2 + (i - 2)) * DFF + f0; *(f32x4*)co = (f32x4){g[0], g[1], g[2], g[3]}; *(f32x4*)(co + 4) = (f32x4){g[4], g[5], g[6], g[7]}; }
        }
    }
}

#define XB_TMO      128
#define XB_XCNT(j)  (256  + 64 * (j))
#define XB_XSUB(j)  (1280 + 64 * (j))
#define XB_XGEN(j)  (2304 + 64 * (j))
#define XB_TOP      3328
#define XB_TOPGEN   3392
#define XCD_BAR_WORDS 3456
#define XB_SPIN_CAP (1u << 18)

__device__ __forceinline__ unsigned xb_ld(unsigned* p)              { return __hip_atomic_load(p, __ATOMIC_RELAXED, __HIP_MEMORY_SCOPE_AGENT); }
__device__ __forceinline__ unsigned xb_add(unsigned* p, unsigned v) { return __hip_atomic_fetch_add(p, v, __ATOMIC_RELAXED, __HIP_MEMORY_SCOPE_AGENT); }
__device__ __forceinline__ unsigned xb_xcc_id() { return (unsigned)__builtin_amdgcn_s_getreg((3 << 11) | 20) & 0xFu; }
#define XB_SPIN(cond, bar) do { unsigned _sp = 0; while (cond) { __builtin_amdgcn_s_sleep(1); \
    if ((++_sp & 255u) == 0u) { if (xb_ld(&(bar)[XB_TMO])) break; if (_sp > XB_SPIN_CAP) { atomicAdd(&(bar)[XB_TMO], 1u); break; } } } } while (0)

struct XcdBarrier {
    unsigned* bar; unsigned x;
    volatile LAS unsigned* st;
};

__device__ __forceinline__ XcdBarrier xcd_barrier_post(unsigned* bar, volatile LAS unsigned* st) {
    XcdBarrier b; b.bar = bar; b.x = xb_xcc_id(); b.st = st;
    if (threadIdx.x == 0) (void)xb_add(&bar[XB_XCNT(b.x)], 1u);
    return b;
}
__device__ __forceinline__ void xcd_barrier_complete(unsigned* bar, unsigned x, unsigned& nloc, unsigned& nx) {
    const unsigned G = gridDim.x * gridDim.y * gridDim.z;
    unsigned sum, cnt, mine, sp = 0u;
    for (;;) {
        sum = 0u; cnt = 0u; mine = 0u;
#pragma unroll
        for (unsigned j = 0; j < 16; ++j) { const unsigned c = xb_ld(&bar[XB_XCNT(j)]); sum += c; cnt += (c > 0u) ? 1u : 0u; mine = (j == x) ? c : mine; }
        if (sum == G) break;
        __builtin_amdgcn_s_sleep(1);
        if ((++sp & 255u) == 0u) { if (xb_ld(&bar[XB_TMO])) break; if (sp > XB_SPIN_CAP) { atomicAdd(&bar[XB_TMO], 1u); break; } }
    }
    nloc = mine > 0u ? mine : 1u; nx = cnt > 0u ? cnt : 1u;
}

__device__ __forceinline__ void xcd_barrier(const XcdBarrier& b) {
    asm volatile("s_waitcnt vmcnt(0)" ::: "memory");
    __syncthreads();
    if (threadIdx.x == 0) {
        unsigned* bar = b.bar;
        __builtin_amdgcn_s_waitcnt(0);
        unsigned nloc = b.st[0], nx = b.st[1];
        if (nloc == 0u) { xcd_barrier_complete(bar, b.x, nloc, nx); b.st[0] = nloc; b.st[1] = nx; }
        const unsigned old = xb_add(&bar[XB_XSUB(b.x)], 1u);
        const unsigned gen = old / nloc;
        if (old + 1u == (gen + 1u) * nloc) {
            __builtin_amdgcn_fence(__ATOMIC_RELEASE, "agent");
            asm volatile("s_waitcnt vmcnt(0)" ::: "memory");
            const unsigned og = xb_add(&bar[XB_TOP], 1u);
            const unsigned tg = og / nx;
            if (og + 1u == (tg + 1u) * nx) xb_add(&bar[XB_TOPGEN], 1u);
            else XB_SPIN(xb_ld(&bar[XB_TOPGEN]) == tg, bar);
            __builtin_amdgcn_fence(__ATOMIC_ACQUIRE, "agent");
            xb_add(&bar[XB_XGEN(b.x)], 1u);
            asm volatile("s_waitcnt vmcnt(0)" ::: "memory");
        } else {
            XB_SPIN(xb_ld(&bar[XB_XGEN(b.x)]) == gen, bar);
            __builtin_amdgcn_fence(__ATOMIC_ACQUIRE, "agent");
            asm volatile("s_waitcnt vmcnt(0)" ::: "memory");
        }
    }
    __syncthreads();
}

__global__ void __launch_bounds__(512, 2) fwd_kernel(Params P) {
    extern __shared__ __attribute__((aligned(16))) unsigned char lds_raw[];
    LAS unsigned char* lds = (LAS unsigned char*)lds_raw;
    const int tid = threadIdx.x, lane = tid & 63, w = __builtin_amdgcn_readfirstlane(tid >> 6);
    const int lo = P.ph_lo, hi = P.ph_hi;
#define IN(k) (lo <= (k) && (k) < hi)
#define SEAM(k) do { if (IN(k) && IN((k) + 1)) { xcd_barrier(bar); } } while (0)
    volatile LAS unsigned* bst = (volatile LAS unsigned*)(lds + LDS_BYTES - 16);
    if (tid < 2) bst[tid] = 0u;
    __syncthreads();
    XcdBarrier bar; bar.bar = (unsigned*)P.ws; bar.x = 0; bar.st = bst;
    if (hi - lo > 1) bar = xcd_barrier_post((unsigned*)P.ws, bst);
    if (hi > 1000) cg::this_grid().sync();
    if (IN(0)) { p0_prologue(P, lds, tid, lane, w); }
    SEAM(0);
    if (IN(1)) { pg8::Gemm g{(const bf16*)(P.ws + WS_HB), (const bf16*)(P.ws + WS_WIN), MT, PW, DM}; pg8::StaticOrder S; S.init(MT, PW, gridDim.x, (int)blockIdx.x, DM);
        pg8::EpiProj E{(bf16*)(P.ws + WS_PROJ), PW}; pg8::gemm_phase<pg8::EpiProj, pg8::StaticOrder, true, true>(lds, g, S, E);
        tail_transposes(P, lds, (MT / 256) * (PW / 256), 0, lane, w); }
    SEAM(1);
    if (IN(2)) {
        if (P.dummy == 0 || P.dummy == 1) for (int u = blockIdx.x; u < 256; u += gridDim.x) swa_prompt_unit(P, lds, gridDim.x == 256 ? (((u & 7) << 5) | (u >> 3)) : u, tid, lane, w);
        if (P.dummy == 0 || P.dummy == 2) for (int u = blockIdx.x; u < 256; u += gridDim.x) { if (u < 128) sample_ret_unit(P, lds, u, tid, lane, w); else sample_swa_unit(P, lds, u - 128, tid, lane, w); }
        if (P.dummy == 1 || P.dummy == 2) {} else if (gridDim.x == 256) {
            const int c = blockIdx.x;
            if (c < 128) { for (int k = 0; k < 3; ++k) ret_l_unit(P, lds, c + 128 * k, tid, lane, w, k & 1); }
            else { for (int k = 0; k < 5; ++k) ret_l_unit(P, lds, 384 + (c - 128) + 128 * k, tid, lane, w, k & 1); }
        } else { int k = 0; for (int u = blockIdx.x; u < 1024; u += gridDim.x, ++k) ret_l_unit(P, lds, u, tid, lane, w, k & 1); }
        __syncthreads();
    }
    SEAM(2);
    if (IN(3)) { }
    if (IN(4)) {
        const float* lbuf = (const float*)(P.ws + WS_LBUF); const int sdv = tid >> 2, sdk = (tid & 3) * 16;
        for (int grp = blockIdx.x; grp < 256; grp += gridDim.x) {
            const int g2 = gridDim.x == 256 ? (((grp & 7) << 5) | (grp >> 3)) : grp;
            const int bh = g2 >> 3, q = g2 & 7; const float g128 = ex2(128.0f * sel_lg2(P, bh & 7));
            float S[16];
#pragma unroll
            for (int e = 0; e < 16; ++e) S[e] = 0.f;
            const float* lp = lbuf + (size_t)(bh * 32) * 8192 + sdv * 64 + sdk;
#pragma unroll 4
            for (int c = 0; c < 4 * q; ++c) { const f32x4 l0 = *(const f32x4*)(lp + (size_t)c * 8192), l1 = *(const f32x4*)(lp + (size_t)c * 8192 + 4), l2 = *(const f32x4*)(lp + (size_t)c * 8192 + 8), l3 = *(const f32x4*)(lp + (size_t)c * 8192 + 12);
#pragma unroll
                for (int e = 0; e < 4; ++e) { S[e] = S[e] * g128 + l0[e]; S[4 + e] = S[4 + e] * g128 + l1[e]; S[8 + e] = S[8 + e] * g128 + l2[e]; S[12 + e] = S[12 + e] * g128 + l3[e]; } }
#pragma unroll 1
            for (int k = 0; k < 4; ++k) ret_c_unit(P, lds, bh * 32 + 4 * q + k, tid, lane, w, k & 1, S, g128);
            if (q == 7) { int sdv2 = sdv, sdk2 = sdk; asm volatile("" : "+v"(sdv2), "+v"(sdk2));
                float* op = P.out + OFF_RET_P + ((size_t)bh * 64 + sdk2) * 128 + sdv2;
#pragma unroll
                for (int e = 0; e < 16; ++e) op[(size_t)e * 128] = S[e]; }
            __syncthreads();
        }
    }
    SEAM(4);
    if (IN(5)) { pg8::Gemm g{(const bf16*)(P.ws + WS_CAT), (const bf16*)(P.ws + WS_WO), MT, DM, DM}; pg8::TailSplitOrder<4> S; S.init(DM, gridDim.x, (int)blockIdx.x, DM, 4);
        pg8::EpiOut E{P.x_prompt, P.x_sample, P.out, (bf16*)(P.ws + WS_HB), (float*)(P.ws + WS_SSQ), (float*)(P.ws + WS_PART), DM / 64}; pg8::gemm_phase<pg8::EpiOut, pg8::TailSplitOrder<4>, true, true>(lds, g, S, E);
        tail_transposes(P, lds, 512 + 64, 1, lane, w); }
    SEAM(5);
    if (IN(6)) {
        const float* part = (const float*)(P.ws + WS_PART); bf16* hb = (bf16*)(P.ws + WS_HB); float* ssq = (float*)(P.ws + WS_SSQ);
        for (int rr = blockIdx.x * 8 + w; rr < 512; rr += gridDim.x * 8) {
            const float* xr = P.x_sample + (size_t)rr * DM; float* orow = P.out + (size_t)(MP + rr) * DM; float ss = 0.f;
#pragma unroll
            for (int j = 0; j < 8; ++j) { const int idx = 4 * lane + 256 * j; f32x4 v = *(const f32x4*)(xr + idx);
#pragma unroll
                for (int ks = 0; ks < 4; ++ks) v = v + *(const f32x4*)(part + (size_t)ks * (512 * 2048) + (size_t)rr * DM + idx);
                *(f32x4*)(orow + idx) = v; u32x2 pk; pk.x = pk2(v[0], v[1]); pk.y = pk2(v[2], v[3]); *(u32x2*)(hb + (size_t)(MP + rr) * DM + idx) = pk;
                ss += (v[0] * v[0] + v[1] * v[1]) + (v[2] * v[2] + v[3] * v[3]); }
            ss = wave_sum(ss); if (lane == 0) ssq[MP + rr] = ss;
        }
    }
    SEAM(6);
    if (IN(7)) { pg8::Gemm g{(const bf16*)(P.ws + WS_HB), (const bf16*)(P.ws + WS_WUP), MT, 2 * DFF, DM}; pg8::StaticOrder S; S.init(MT, 2 * DFF, gridDim.x, (int)blockIdx.x, DM);
        pg8::EpiUpAct E{(bf16*)(P.ws + WS_U), (bf16*)(P.ws + WS_GSB), (bf16*)(P.ws + WS_USB), (float*)(P.ws + WS_GHF), (float*)(P.ws + WS_UHF), (float*)(P.ws + WS_GHL), (const float*)(P.ws + WS_SSQ), P.conv_w, P.conv_b, (LAS float*)(lds + 131072)};
        pg8::gemm_phase<pg8::EpiUpAct, pg8::StaticOrder, true, true>(lds, g, S, E);
        tail_transposes(P, lds, (MT / 256) * (2 * DFF / 256), 2, lane, w); }
    SEAM(7);
    if (IN(8)) { act_fixup(P, tid, lane, w); }
    SEAM(8);
    if (IN(9)) { pg8::Gemm g{(const bf16*)(P.ws + WS_U), (const bf16*)(P.ws + WS_WDN), MT, DM, DFF, 1}; pg8::TailSplitOrder<KSPLIT> S; S.init(DM, gridDim.x, (int)blockIdx.x, DFF, 4);
        pg8::EpiDown E{P.dummy ? (float*)(P.ws + WS_G) : P.out, DFF / 64, (const bf16*)(P.ws + WS_HB), (float*)(P.ws + WS_PART)}; pg8::gemm_phase<pg8::EpiDown, pg8::TailSplitOrder<KSPLIT>, true, true>(lds, g, S, E); }
    SEAM(9);
    if (IN(10)) {
        const float* part = (const float*)(P.ws + WS_PART); float* o = P.out + (size_t)MP * DM;
        for (int idx = blockIdx.x * 512 + tid; idx < 512 * 2048 / 4; idx += gridDim.x * 512) { f32x4 v = *(const f32x4*)(o + 4 * (size_t)idx);
#pragma unroll
            for (int ks = 0; ks < KSPLIT; ++ks) v = v + *(const f32x4*)(part + (size_t)ks * (512 * 2048) + 4 * (size_t)idx);
            *(f32x4*)(o + 4 * (size_t)idx) = v; }
    }
#undef IN
#undef SEAM
}

extern "C" void kernel_launch(void* const* d_in, const int* in_sizes, int n_in, void* d_out, int out_size, void* d_ws, size_t ws_size, hipStream_t stream) {
    static int grid = 0;
    if (grid == 0) {
        if (n_in != 18 || in_sizes[0] != MP * DM || (size_t)out_size != OUT_TOTAL || ws_size < WS_END) {
            fprintf(stderr, "kernel_launch: unexpected shapes: n_in %d in0 %d out %d ws %zu (need %zu)\n", n_in, n_in > 0 ? in_sizes[0] : -1, out_size, ws_size, (size_t)WS_END); grid = -1; return; }
        int dev = 0, cus = 0, per_cu = 0;
        if (hipGetDevice(&dev) != hipSuccess || hipDeviceGetAttribute(&cus, hipDeviceAttributeMultiprocessorCount, dev) != hipSuccess) { grid = -1; return; }
        if (hipFuncSetAttribute((const void*)fwd_kernel, hipFuncAttributeMaxDynamicSharedMemorySize, LDS_BYTES) != hipSuccess) { fprintf(stderr, "kernel_launch: hipFuncSetAttribute failed\n"); grid = -1; return; }
        if (hipOccupancyMaxActiveBlocksPerMultiprocessor(&per_cu, (const void*)fwd_kernel, 512, LDS_BYTES) != hipSuccess || per_cu < 1) { fprintf(stderr, "kernel_launch: occupancy query says %d\n", per_cu); per_cu = 1; }
        (void)hipGetLastError();
        grid = cus * 1;
    }
    if (grid < 0) return;
    Params p{};
    p.x_prompt = (const float*)d_in[0]; p.x_sample = (const float*)d_in[1]; p.state_ret = (const float*)d_in[2]; p.cache_k = (const float*)d_in[3]; p.cache_v = (const float*)d_in[4];
    p.state_conv = (const float*)d_in[5]; p.attn_norm_w = (const float*)d_in[6]; p.w_in = (const float*)d_in[7]; p.q_norm_w = (const float*)d_in[8]; p.k_norm_w = (const float*)d_in[9];
    p.sinks = (const float*)d_in[10]; p.gn_w = (const float*)d_in[11]; p.w_o = (const float*)d_in[12]; p.ffn_norm_w = (const float*)d_in[13]; p.w_up = (const float*)d_in[14];
    p.conv_w = (const float*)d_in[15]; p.conv_b = (const float*)d_in[16]; p.w_down = (const float*)d_in[17];
    p.out = (float*)d_out; p.ws = (unsigned char*)d_ws;
    for (int i = 0; i < 32; ++i) p.inv_freq[i] = (float)pow(10000.0, -(double)i / 32.0);
    for (int h = 0; h < 8; ++h) p.lg2[h] = (float)log2(1.0 - exp2(-5.0 - (double)h));
#if MK_N_LAUNCHES == 1
    p.ph_lo = 0; p.ph_hi = NPH;
    if (hipMemsetAsync(d_ws, 0, 16384, stream) != hipSuccess) { fprintf(stderr, "kernel_launch: memset failed\n"); return; }
    void* args[] = {&p};
    hipError_t e = hipLaunchCooperativeKernel((const void*)fwd_kernel, dim3(grid), dim3(512), args, LDS_BYTES, stream);
    if (e != hipSuccess) fprintf(stderr, "kernel_launch: cooperative launch failed: %s (grid %d)\n", hipGetErrorString(e), grid);
#else
    {
        const int seq[] = PROBE_SEQ;
        for (unsigned k = 0; k < sizeof(seq) / sizeof(seq[0]); ++k) { p.ph_lo = seq[k] % 100; p.ph_hi = p.ph_lo + 1; p.dummy = seq[k] / 100; hipLaunchKernelGGL(fwd_kernel, dim3(grid), dim3(512), LDS_BYTES, stream, p); }
    }
#endif
}
```
